# Optimizing an MI355X kernel written in HIP

```python
import math
import jax, jax.numpy as jnp
from jax import lax
import numpy as np

D_MODEL = 2048
BATCH = 4
SEQ = 2048
DEPTH = 1
DEC_BATCH = 128
DEC_SEQ = 1
PAST_LEN = 16384
PAGE_SIZE = 128

D_MIX = D_MODEL
D_A = D_MIX // 2
D_B = D_MIX - D_A
CHUNK = 128
HEAD_A = 128
N_HEADS_A = D_A // HEAD_A
GROUP_B = 16
N_GROUPS_B = D_B // GROUP_B
P_STATE = 64
D_IN = 3 * D_A + 2 * D_B
EPS = 1e-6
DT_MIN = 1e-3
DT_MAX = 1e-1

kernel_name = "hymba_gmlp_s5_decode_step"


def rmsnorm(x, g):
    xf = x.astype(jnp.float32)
    r = xf * lax.rsqrt(jnp.mean(xf * xf, axis=-1, keepdims=True) + EPS)
    return (r * g.astype(jnp.float32)).astype(x.dtype)


def layernorm(x, g, b):
    xf = x.astype(jnp.float32)
    mu = jnp.mean(xf, axis=-1, keepdims=True)
    xc = xf - mu
    r = xc * lax.rsqrt(jnp.mean(xc * xc, axis=-1, keepdims=True) + EPS)
    return (r * g.astype(jnp.float32) + b.astype(jnp.float32)).astype(x.dtype)


def adaln(c, w_c, b_c):
    m = jax.nn.silu(c) @ w_c + b_c
    return jnp.split(m, 3, axis=-1)


def chunk_mix(v, w_s, b_s):
    n, L, H, dh = v.shape
    n_chunks = -(-L // CHUNK)
    pad = n_chunks * CHUNK - L
    vp = jnp.pad(v, ((0, 0), (0, pad), (0, 0), (0, 0)))
    vc = vp.reshape(n, n_chunks, CHUNK, H, dh)
    ws = jnp.tril(w_s)
    out = jnp.einsum('hts,bcshd->bcthd', ws, vc) + b_s.T[None, None, :, :, None]
    return out.reshape(n, n_chunks * CHUNK, H, dh)[:, :L]


def s5_discretize(a_re, a_im, log_dt, b_re, b_im):
    a_re = a_re.astype(jnp.float32)
    a_im = a_im.astype(jnp.float32)
    dt = jnp.exp(log_dt.astype(jnp.float32))[:, None]
    mag = jnp.exp(dt * a_re)
    abar_re = mag * jnp.cos(dt * a_im)
    abar_im = mag * jnp.sin(dt * a_im)
    num_re = abar_re - 1.0
    num_im = abar_im
    den = a_re * a_re + a_im * a_im
    coef_re = (num_re * a_re + num_im * a_im) / den
    coef_im = (num_im * a_re - num_re * a_im) / den
    b_re = b_re.astype(jnp.float32)
    b_im = b_im.astype(jnp.float32)
    bbar_re = coef_re[..., None] * b_re - coef_im[..., None] * b_im
    bbar_im = coef_re[..., None] * b_im + coef_im[..., None] * b_re
    return abar_re, abar_im, bbar_re, bbar_im


def _scan_combine(e1, e2):
    a1r, a1i, b1r, b1i = e1
    a2r, a2i, b2r, b2i = e2
    ar = a2r * a1r - a2i * a1i
    ai = a2r * a1i + a2i * a1r
    br = a2r * b1r - a2i * b1i + b2r
    bi = a2r * b1i + a2i * b1r + b2i
    return ar, ai, br, bi


def s5_branch(xb, h0_re, h0_im, a_re, a_im, log_dt, b_re, b_im, c_re, c_im, d_skip, w_glu, b_glu):
    abar_re, abar_im, bbar_re, bbar_im = s5_discretize(a_re, a_im, log_dt, b_re, b_im)
    bu_re = jnp.einsum('nlgc,gpc->nlgp', xb, bbar_re)
    bu_im = jnp.einsum('nlgc,gpc->nlgp', xb, bbar_im)
    bu_re = bu_re.at[:, 0].add(abar_re * h0_re - abar_im * h0_im)
    bu_im = bu_im.at[:, 0].add(abar_re * h0_im + abar_im * h0_re)
    ar = jnp.broadcast_to(abar_re, bu_re.shape)
    ai = jnp.broadcast_to(abar_im, bu_re.shape)
    _, _, h_re, h_im = lax.associative_scan(_scan_combine, (ar, ai, bu_re, bu_im), axis=1)
    d = d_skip.astype(jnp.float32).reshape(N_GROUPS_B, GROUP_B)
    y = (jnp.einsum('nlgp,gcp->nlgc', h_re, c_re.astype(jnp.float32))
         - jnp.einsum('nlgp,gcp->nlgc', h_im, c_im.astype(jnp.float32))
         + d * xb)
    g = jnp.einsum('nlgc,gce->nlge', y, w_glu.astype(jnp.float32)) + b_glu.astype(jnp.float32)
    y = g[..., :GROUP_B] * jax.nn.sigmoid(g[..., GROUP_B:])
    return y, h_re[:, -1], h_im[:, -1]


def hybrid_layer(x, c, h0_re, h0_im, w_c, b_c, g_pre, w_in, ln_v_g, ln_v_b, w_s, b_s,
                 a_re, a_im, log_dt, b_re, b_im, c_re, c_im, d_skip, w_glu, b_glu, w_out, g_post):
    n, L, _ = x.shape
    shift, scale, gate = adaln(c, w_c, b_c)
    h = rmsnorm(x, g_pre) * (1.0 + scale[:, None, :]) + shift[:, None, :]
    proj = h @ w_in
    u_a, v_a, z_a, x_b, z_b = jnp.split(
        proj, [D_A, 2 * D_A, 3 * D_A, 3 * D_A + D_B], axis=-1)
    v_a = layernorm(v_a, ln_v_g, ln_v_b)
    mix = chunk_mix(v_a.reshape(n, L, N_HEADS_A, HEAD_A), w_s, b_s).reshape(n, L, D_A)
    y_a = u_a * mix * jax.nn.silu(z_a)
    xb = x_b.reshape(n, L, N_GROUPS_B, GROUP_B).astype(jnp.float32)
    y_b, h_re, h_im = s5_branch(xb, h0_re, h0_im, a_re, a_im, log_dt, b_re, b_im,
                                c_re, c_im, d_skip, w_glu, b_glu)
    y_b = y_b.reshape(n, L, D_B).astype(x.dtype) * jax.nn.silu(z_b)
    o = jnp.concatenate([y_a, y_b], axis=-1) @ w_out
    out = x + gate[:, None, :] * rmsnorm(o, g_post)
    return out, v_a, h_re, h_im


def setup_inputs(seed: int = 0) -> dict:
    key = jax.random.key(seed)
    ks = jax.random.split(key, 32)
    f32 = jnp.float32
    nrm = lambda k, s: jax.random.normal(k, s, f32)
    x_prompt = nrm(ks[0], (BATCH, SEQ, D_MODEL))
    x_sample = nrm(ks[1], (DEC_BATCH, DEC_SEQ, D_MODEL))
    c_prompt = nrm(ks[2], (BATCH, D_MODEL))
    c_sample = nrm(ks[3], (DEC_BATCH, D_MODEL))
    state_b_re = 0.3 * nrm(ks[4], (DEC_BATCH, N_GROUPS_B, P_STATE))
    state_b_im = 0.3 * nrm(ks[5], (DEC_BATCH, N_GROUPS_B, P_STATE))
    w_c = 0.2 * nrm(ks[6], (D_MODEL, 3 * D_MODEL)) * D_MODEL ** -0.5
    b_c = 0.02 * nrm(ks[7], (3 * D_MODEL,))
    g_pre = 1.0 + 0.05 * nrm(ks[8], (D_MODEL,))
    w_in = nrm(ks[9], (D_MODEL, D_IN)) * D_MODEL ** -0.5
    ln_v_g = 1.0 + 0.05 * nrm(ks[10], (D_A,))
    ln_v_b = 0.02 * nrm(ks[11], (D_A,))
    w_s = nrm(ks[12], (N_HEADS_A, CHUNK, CHUNK)) * CHUNK ** -0.5
    b_s = 1.0 + 0.1 * nrm(ks[13], (N_HEADS_A, CHUNK))
    a_re = -0.5 + 0.01 * nrm(ks[14], (N_GROUPS_B, P_STATE))
    a_im = math.pi * jnp.arange(P_STATE, dtype=f32)[None, :] + 0.01 * nrm(ks[15], (N_GROUPS_B, P_STATE))
    log_dt = jax.random.uniform(ks[16], (N_GROUPS_B,), f32, math.log(DT_MIN), math.log(DT_MAX))
    b_scale = (2.0 * GROUP_B) ** -0.5
    b_re = b_scale * nrm(ks[17], (N_GROUPS_B, P_STATE, GROUP_B))
    b_im = b_scale * nrm(ks[18], (N_GROUPS_B, P_STATE, GROUP_B))
    c_scale = (2.0 * P_STATE) ** -0.5
    c_re = c_scale * nrm(ks[19], (N_GROUPS_B, GROUP_B, P_STATE))
    c_im = c_scale * nrm(ks[20], (N_GROUPS_B, GROUP_B, P_STATE))
    d_skip = nrm(ks[21], (D_B,))
    w_glu = nrm(ks[22], (N_GROUPS_B, GROUP_B, 2 * GROUP_B)) * GROUP_B ** -0.5
    b_glu = 0.02 * nrm(ks[23], (N_GROUPS_B, 2 * GROUP_B))
    w_out = nrm(ks[24], (D_MIX, D_MODEL)) * D_MIX ** -0.5
    g_post = 1.0 + 0.05 * nrm(ks[25], (D_MODEL,))
    return {"x_prompt": x_prompt, "x_sample": x_sample, "c_prompt": c_prompt, "c_sample": c_sample,
            "state_b_re": state_b_re, "state_b_im": state_b_im,
            "w_c": w_c, "b_c": b_c, "g_pre": g_pre, "w_in": w_in, "ln_v_g": ln_v_g, "ln_v_b": ln_v_b,
            "w_s": w_s, "b_s": b_s, "a_re": a_re, "a_im": a_im, "log_dt": log_dt,
            "b_re": b_re, "b_im": b_im, "c_re": c_re, "c_im": c_im, "d_skip": d_skip,
            "w_glu": w_glu, "b_glu": b_glu, "w_out": w_out, "g_post": g_post}


def reference(x_prompt, x_sample, c_prompt, c_sample, state_b_re, state_b_im,
              w_c, b_c, g_pre, w_in, ln_v_g, ln_v_b, w_s, b_s, a_re, a_im, log_dt,
              b_re, b_im, c_re, c_im, d_skip, w_glu, b_glu, w_out, g_post):
    y_prompt = x_prompt
    y_sample = x_sample
    for layer in range(DEPTH):
        h0_re_p = jnp.zeros((x_prompt.shape[0], N_GROUPS_B, P_STATE), jnp.float32)
        h0_im_p = jnp.zeros((x_prompt.shape[0], N_GROUPS_B, P_STATE), jnp.float32)
        y_prompt, _, hp_re, hp_im = hybrid_layer(
            y_prompt, c_prompt, h0_re_p, h0_im_p, w_c, b_c, g_pre, w_in, ln_v_g, ln_v_b, w_s, b_s,
            a_re, a_im, log_dt, b_re, b_im, c_re, c_im, d_skip, w_glu, b_glu, w_out, g_post)
        y_sample, v_s, hs_re, hs_im = hybrid_layer(
            y_sample, c_sample, state_b_re.astype(jnp.float32), state_b_im.astype(jnp.float32),
            w_c, b_c, g_pre, w_in, ln_v_g, ln_v_b, w_s, b_s,
            a_re, a_im, log_dt, b_re, b_im, c_re, c_im, d_skip, w_glu, b_glu, w_out, g_post)
    return (y_prompt, y_sample, v_s, hp_re, hp_im, hs_re, hs_im)
```

```cpp
#include <hip/hip_runtime.h>
#include <cstdio>
#include <cstdint>

#ifndef MK_N_LAUNCHES
#define MK_N_LAUNCHES 1
#endif

namespace pg8 {
#define PG8_LAS __attribute__((address_space(3)))
typedef unsigned short bf16_t;
typedef short bf16x8 __attribute__((ext_vector_type(8)));
typedef float f32x4 __attribute__((ext_vector_type(4)));
typedef unsigned u32x4 __attribute__((ext_vector_type(4)));
constexpr int BM = 256, BK = 64, HALF = 128, HTB = HALF * BK * 2  , STAGE_BYTES = 8 * HTB, NXCD = 8, WGM = 8;

__host__ __device__ __forceinline__ int lds_byte(int r, int c) { const int st = (r >> 4) * 2 + (c >> 5), rr = r & 15, cc = c & 31, ob = rr * 64 + cc * 2; return st * 1024 + (ob ^ (((ob >> 9) & 1) << 5)); }
__host__ __device__ __forceinline__ void stage_rc(int b, int& R, int& C) { const int st = b / 1024, sb = b % 1024, swz = sb ^ (((sb >> 9) & 1) << 5); R = (st >> 1) * 16 + swz / 64; C = (st & 1) * 32 + (swz % 64) / 2; }
__host__ __device__ __forceinline__ int perm32(int rho) { const int n = rho >> 4, i = rho & 15; return 8 * (i >> 2) + 4 * n + (i & 3); }

struct Unit { int pm, pn; };
struct Gemm { const bf16_t* A; const bf16_t* Bt; int M, N, K; };

struct StaticOrder {
    int nM, nN, nwg, G, c;
    __host__ __device__ void init(int M, int N, int G_, int c_) { nM = M / BM; nN = N / BM; nwg = nM * nN; G = G_; c = c_; }
    __host__ __device__ bool next(int i, Unit& u) const {
        const long L = (long)i * G + c; if (L >= nwg) return false;
        int wgid = (int)L; { const int q = nwg / NXCD, r = nwg % NXCD, xcd = wgid % NXCD, off = wgid / NXCD; wgid = (xcd < r ? xcd * (q + 1) : r * (q + 1) + (xcd - r) * q) + off; }
        const int nig = WGM * nN, gid = wgid / nig, fm = gid * WGM, gsz = (nM - fm) < WGM ? (nM - fm) : WGM;
        u.pm = fm + ((wgid % nig) % gsz); u.pn = (wgid % nig) / gsz; return true;
    }
    __device__ __forceinline__ void a_ready(const Unit&) const {}
    __device__ __forceinline__ void done(const Unit&) const {}
};

typedef float f32x2_t __attribute__((ext_vector_type(2)));
typedef __bf16 bf16x2_t __attribute__((ext_vector_type(2)));
__device__ __forceinline__ unsigned cvt_pk_bf16(float lo, float hi) { const f32x2_t v = {lo, hi}; return __builtin_bit_cast(unsigned, __builtin_convertvector(v, bf16x2_t)); }
__device__ __forceinline__ float silu_f(float x) { return x * __builtin_amdgcn_rcpf(1.0f + __expf(-x)); }

struct EpiProj {
    static constexpr bool PERM = true, AFTER_DRAIN = false;
    bf16_t* P; float* vstat;
    __device__ __forceinline__ void operator()(const f32x4 (&acc)[2][2][4][2], const Unit& u, int wr, int wc, int fr, int fq) const {
        const int row0 = u.pm * BM + wr * 64 + fr, col0 = u.pn * BM + wc * 32 + 8 * fq;
        const int type = u.pn >> 2;
        const bool act = (type == 2) || (type == 4), stat = (type == 1);
#pragma unroll
        for (int ai = 0; ai < 2; ++ai)
#pragma unroll
            for (int m = 0; m < 4; ++m) { const int row = row0 + ai * HALF + m * 16; bf16_t* rowp = P + (size_t)row * 5120 + col0; float s1 = 0.f, s2 = 0.f;
#pragma unroll
                for (int bj = 0; bj < 2; ++bj) { f32x4 v0 = acc[ai][bj][m][0], v1 = acc[ai][bj][m][1];
                    if (act) {
#pragma unroll
                        for (int j = 0; j < 4; ++j) { v0[j] = silu_f(v0[j]); v1[j] = silu_f(v1[j]); } }
                    if (stat) {
#pragma unroll
                        for (int j = 0; j < 4; ++j) { s1 += v0[j] + v1[j]; s2 += v0[j] * v0[j] + v1[j] * v1[j]; } }
                    u32x4 w; w.x = cvt_pk_bf16(v0[0], v0[1]); w.y = cvt_pk_bf16(v0[2], v0[3]); w.z = cvt_pk_bf16(v1[0], v1[1]); w.w = cvt_pk_bf16(v1[2], v1[3]);
                    *(u32x4*)(rowp + bj * HALF) = w; }
                if (stat) { s1 += __shfl_xor(s1, 16); s1 += __shfl_xor(s1, 32); s2 += __shfl_xor(s2, 16); s2 += __shfl_xor(s2, 32);
                    if (fq == 0) { atomicAdd(vstat + 2 * row, s1); atomicAdd(vstat + 2 * row + 1, s2); } } }
    }
};
struct EpiO {
    static constexpr bool PERM = true, AFTER_DRAIN = false;
    bf16_t* O; float* osq;
    __device__ __forceinline__ void operator()(const f32x4 (&acc)[2][2][4][2], const Unit& u, int wr, int wc, int fr, int fq) const {
        const int row0 = u.pm * BM + wr * 64 + fr, col0 = u.pn * BM + wc * 32 + 8 * fq;
#pragma unroll
        for (int ai = 0; ai < 2; ++ai)
#pragma unroll
            for (int m = 0; m < 4; ++m) { const int row = row0 + ai * HALF + m * 16; bf16_t* rowp = O + (size_t)row * 2048 + col0; float s2 = 0.f;
#pragma unroll
                for (int bj = 0; bj < 2; ++bj) { const f32x4 v0 = acc[ai][bj][m][0], v1 = acc[ai][bj][m][1];
#pragma unroll
                    for (int j = 0; j < 4; ++j) s2 += v0[j] * v0[j] + v1[j] * v1[j];
                    u32x4 w; w.x = cvt_pk_bf16(v0[0], v0[1]); w.y = cvt_pk_bf16(v0[2], v0[3]); w.z = cvt_pk_bf16(v1[0], v1[1]); w.w = cvt_pk_bf16(v1[2], v1[3]);
                    *(u32x4*)(rowp + bj * HALF) = w; }
                s2 += __shfl_xor(s2, 16); s2 += __shfl_xor(s2, 32);
                if (fq == 0) atomicAdd(osq + row, s2); }
    }
};

template <class Epi, class Sched, bool ALIGN_EPI = false, bool SP2 = false>
__device__ __forceinline__ void gemm_phase(PG8_LAS unsigned char* lds, const Gemm g, const Sched& S, const Epi& E) {
    const int tid = threadIdx.x, wid = __builtin_amdgcn_readfirstlane(tid >> 6), lane = tid & 63, wr = wid >> 2, wc = wid & 3, fr = lane & 15, fq = lane >> 4;
    const int K = g.K, nt = K / BK;
    unsigned voffA[2], voffB[2];
#pragma unroll
    for (int i = 0; i < 2; ++i) { int R, C; stage_rc(tid * 16 + i * 8192, R, C); const int Rb = Epi::PERM ? ((R & ~31) + perm32(R & 31)) : R;
        voffA[i] = (unsigned)(R * K + C) * 2u; voffB[i] = (unsigned)(Rb * K + C) * 2u; }
    const size_t kstep = (size_t)(BK * 2);
    const size_t hstep = (size_t)HALF * K * 2;
    const size_t tstep = 2 * hstep;
    const unsigned ldsw = (unsigned)wid * 1024u;
    const int aoff = lds_byte(wr * 64 + fr, fq * 8), boff = lds_byte(wc * 32 + fr, fq * 8);
#define PG8_SA(b, h) (((b) * 2 + (h)) * HTB)
#define PG8_SB(b, h) ((4 + (b) * 2 + (h)) * HTB)
#define PG8_STAGE(bufoff, gbase, voff) do { _Pragma("unroll") for (int _i = 0; _i < 2; ++_i) \
        __builtin_amdgcn_global_load_lds((const unsigned*)((const char*)(gbase) + (voff)[_i]), (PG8_LAS unsigned*)(lds + (bufoff) + ldsw + _i * 8192), 16, 0, 0); } while (0)
#define PG8_LDA(dst, b, h) do { _Pragma("unroll") for (int m = 0; m < 4; ++m) _Pragma("unroll") for (int k = 0; k < 2; ++k) dst[m][k] = *(const PG8_LAS bf16x8*)(lds + PG8_SA(b, h) + aoff + m * 2048 + k * 1024); } while (0)
#define PG8_LDB(dst, b, h) do { _Pragma("unroll") for (int n = 0; n < 2; ++n) _Pragma("unroll") for (int k = 0; k < 2; ++k) dst[n][k] = *(const PG8_LAS bf16x8*)(lds + PG8_SB(b, h) + boff + n * 2048 + k * 1024); } while (0)
#define PG8_MMA(ai, bj, At, Bt) do { __builtin_amdgcn_s_setprio(1); _Pragma("unroll") for (int m = 0; m < 4; ++m) _Pragma("unroll") for (int n = 0; n < 2; ++n) _Pragma("unroll") for (int k = 0; k < 2; ++k) \
        acc[ai][bj][m][n] = __builtin_amdgcn_mfma_f32_16x16x32_bf16(Bt[n][k], At[m][k], acc[ai][bj][m][n], 0, 0, 0); __builtin_amdgcn_s_setprio(0); } while (0)
#define PG8_WAIT_V(n) asm volatile("s_waitcnt vmcnt(" #n ")" ::: "memory")
#define PG8_WAIT_L(n) asm volatile("s_waitcnt lgkmcnt(" #n ")" ::: "memory")
#define PG8_BAR __builtin_amdgcn_s_barrier()
#define PG8_SCHED __builtin_amdgcn_sched_barrier(0)
    Unit cur, nxt; int ui = 0;
    if (!S.next(0, cur)) return;
    f32x4 acc[2][2][4][2];
#pragma unroll
    for (int a = 0; a < 2; ++a)
#pragma unroll
        for (int b = 0; b < 2; ++b)
#pragma unroll
            for (int m = 0; m < 4; ++m)
#pragma unroll
                for (int n = 0; n < 2; ++n) acc[a][b][m][n] = (f32x4){0.f, 0.f, 0.f, 0.f};
    bf16x8 At[4][2], B0[2][2], B1[2][2];
    const char* cA = (const char*)g.A + (size_t)cur.pm * tstep; const char* cB = (const char*)g.Bt + (size_t)cur.pn * tstep;
    S.a_ready(cur);
    if constexpr (SP2) {
        PG8_STAGE(PG8_SB(0, 0), cB, voffB); PG8_STAGE(PG8_SB(0, 1), cB + hstep, voffB); PG8_STAGE(PG8_SA(0, 0), cA, voffA); PG8_STAGE(PG8_SA(0, 1), cA + hstep, voffA);
        if (wr == 1) PG8_BAR;
        PG8_WAIT_V(2); PG8_BAR;
        PG8_STAGE(PG8_SB(1, 0), cB + kstep, voffB); PG8_STAGE(PG8_SA(1, 0), cA + kstep, voffA); PG8_STAGE(PG8_SB(1, 1), cB + hstep + kstep, voffB);
        PG8_WAIT_V(6); PG8_BAR;
    } else {
        PG8_STAGE(PG8_SB(0, 0), cB, voffB); PG8_STAGE(PG8_SA(0, 0), cA, voffA); PG8_STAGE(PG8_SB(0, 1), cB + hstep, voffB); PG8_STAGE(PG8_SA(0, 1), cA + hstep, voffA);
        if (wr == 1) PG8_BAR;
        PG8_WAIT_V(4); PG8_BAR;
        PG8_STAGE(PG8_SB(1, 0), cB + kstep, voffB); PG8_STAGE(PG8_SA(1, 0), cA + kstep, voffA); PG8_STAGE(PG8_SB(1, 1), cB + hstep + kstep, voffB);
        PG8_WAIT_V(6); PG8_BAR;
    }
    for (;;) {
        const bool has_next = S.next(ui + 1, nxt);
        const char* nA = has_next ? (const char*)g.A + (size_t)nxt.pm * tstep : cA; const char* nB = has_next ? (const char*)g.Bt + (size_t)nxt.pn * tstep : cB;
        for (int t = 0; t < nt; t += 2) {
            const bool last = (t == nt - 2);
            const char* a1 = cA + (size_t)(t + 1) * kstep;
            const char* a2 = last ? nA : cA + (size_t)(t + 2) * kstep; const char* b2 = last ? nB : cB + (size_t)(t + 2) * kstep;
            const char* a3 = a2 + kstep; const char* b3 = b2 + kstep;
            if (last && has_next) S.a_ready(nxt);
            if constexpr (SP2) {
            PG8_LDB(B0, 0, 0); PG8_LDB(B1, 0, 1); PG8_SCHED; PG8_LDA(At, 0, 0); PG8_STAGE(PG8_SA(1, 1), a1 + hstep, voffA);
            PG8_WAIT_V(8); PG8_WAIT_L(0); PG8_BAR; PG8_MMA(0, 0, At, B0); PG8_MMA(0, 1, At, B1); PG8_BAR; PG8_SCHED;
            PG8_LDA(At, 0, 1); PG8_STAGE(PG8_SB(0, 0), b2, voffB); PG8_STAGE(PG8_SB(0, 1), b2 + hstep, voffB); PG8_STAGE(PG8_SA(0, 0), a2, voffA);
            PG8_WAIT_V(8); PG8_WAIT_L(0); PG8_BAR; PG8_MMA(1, 0, At, B0); PG8_MMA(1, 1, At, B1); PG8_BAR; PG8_SCHED;
            PG8_LDB(B0, 1, 0); PG8_LDB(B1, 1, 1); PG8_SCHED; PG8_LDA(At, 1, 0); PG8_STAGE(PG8_SA(0, 1), a2 + hstep, voffA);
            PG8_WAIT_V(8); PG8_WAIT_L(0); PG8_BAR; PG8_MMA(0, 0, At, B0); PG8_MMA(0, 1, At, B1); PG8_BAR; PG8_SCHED;
            PG8_LDA(At, 1, 1); PG8_STAGE(PG8_SB(1, 0), b3, voffB); PG8_STAGE(PG8_SB(1, 1), b3 + hstep, voffB); PG8_STAGE(PG8_SA(1, 0), a3, voffA);
            PG8_WAIT_V(8); PG8_WAIT_L(0); PG8_BAR; PG8_MMA(1, 0, At, B0); PG8_MMA(1, 1, At, B1); PG8_BAR; PG8_SCHED;
            } else {
            PG8_LDB(B0, 0, 0); PG8_SCHED; PG8_LDA(At, 0, 0); PG8_STAGE(PG8_SA(1, 1), a1 + hstep, voffA);
            PG8_WAIT_L(8); PG8_BAR; PG8_WAIT_L(0); PG8_MMA(0, 0, At, B0); PG8_BAR; PG8_SCHED;
            PG8_LDB(B1, 0, 1); PG8_STAGE(PG8_SB(0, 0), b2, voffB);
            PG8_BAR; PG8_WAIT_L(0); PG8_MMA(0, 1, At, B1); PG8_BAR;
            PG8_LDA(At, 0, 1); PG8_STAGE(PG8_SA(0, 0), a2, voffA);
            PG8_BAR; PG8_WAIT_L(0); PG8_MMA(1, 0, At, B0); PG8_BAR; PG8_SCHED;
            PG8_STAGE(PG8_SB(0, 1), b2 + hstep, voffB);
            PG8_WAIT_V(6); PG8_BAR; PG8_MMA(1, 1, At, B1); PG8_BAR;
            PG8_LDB(B0, 1, 0); PG8_SCHED; PG8_LDA(At, 1, 0); PG8_STAGE(PG8_SA(0, 1), a2 + hstep, voffA);
            PG8_WAIT_L(8); PG8_BAR; PG8_WAIT_L(0); PG8_MMA(0, 0, At, B0); PG8_BAR; PG8_SCHED;
            PG8_LDB(B1, 1, 1); PG8_STAGE(PG8_SB(1, 0), b3, voffB);
            PG8_BAR; PG8_WAIT_L(0); PG8_MMA(0, 1, At, B1); PG8_BAR;
            PG8_LDA(At, 1, 1); PG8_STAGE(PG8_SA(1, 0), a3, voffA);
            PG8_BAR; PG8_WAIT_L(0); PG8_MMA(1, 0, At, B0); PG8_BAR; PG8_SCHED;
            PG8_STAGE(PG8_SB(1, 1), b3 + hstep, voffB);
            PG8_WAIT_V(6); PG8_BAR; PG8_MMA(1, 1, At, B1); PG8_BAR;
            }
        }
        if constexpr (ALIGN_EPI) { if (wr == 0) PG8_BAR; }
        if constexpr (!Epi::AFTER_DRAIN) { E(acc, cur, wr, wc, fr, fq); S.done(cur); }
        if (!has_next) break;
#pragma unroll
        for (int a = 0; a < 2; ++a)
#pragma unroll
            for (int b = 0; b < 2; ++b)
#pragma unroll
                for (int m = 0; m < 4; ++m)
#pragma unroll
                    for (int n = 0; n < 2; ++n) acc[a][b][m][n] = (f32x4){0.f, 0.f, 0.f, 0.f};
        cur = nxt; cA = nA; cB = nB; ++ui;
        if constexpr (ALIGN_EPI) { if (wr == 1) PG8_BAR; }
    }
    PG8_WAIT_V(0);
    if constexpr (!ALIGN_EPI) { if (wr == 0) PG8_BAR; }
    PG8_BAR;
#undef PG8_SA
#undef PG8_SB
#undef PG8_STAGE
#undef PG8_LDA
#undef PG8_LDB
#undef PG8_MMA
#undef PG8_WAIT_V
#undef PG8_WAIT_L
#undef PG8_BAR
#undef PG8_SCHED
}
}

constexpr int NWAVES = 8;
constexpr int N_LAUNCHES = MK_N_LAUNCHES;
constexpr int PER_PHASE = 7;
constexpr int DM = 2048, NBATCH = 4, SEQ = 2048, DEC = 128;
constexpr int MTOK = NBATCH * SEQ + DEC;
constexpr int MP = 8448;
constexpr int DA = 1024, DIN = 5120, NCOND = NBATCH + DEC;
constexpr int NG = 64, PST = 64;
constexpr float EPS = 1e-6f;
constexpr size_t OUT_VS = (size_t)MTOK * DM, OUT_HPRE = OUT_VS + (size_t)DEC * DA, OUT_HPIM = OUT_HPRE + NBATCH * NG * PST,
                 OUT_HSRE = OUT_HPIM + NBATCH * NG * PST, OUT_HSIM = OUT_HSRE + (size_t)DEC * NG * PST;
constexpr size_t MiB = 1u << 20;
constexpr size_t WS_CTL = 0, CTL_ZERO_BYTES = 1 * MiB;
constexpr size_t WS_WIN = 2 * MiB, WS_WOUT = 22 * MiB, WS_SC = 30 * MiB, WS_MOD = 31 * MiB, WS_S5C = 35 * MiB;
constexpr size_t WS_H = 36 * MiB, WS_PROJ = 69 * MiB, WS_Y = 152 * MiB, WS_O = 185 * MiB, WS_END = 218 * MiB;
constexpr size_t S5C_ABAR = 0, S5C_A16 = 32768, S5C_A256 = 65536, S5C_BBAR = 131072;
constexpr int CW_BAR = 4096, CW_VSTAT = 32768, CW_OSQ = 65536;
constexpr int RING_BYTES = 131072, LDSCTL_OFF = 143360, MISC_OFF = LDSCTL_OFF + 320, LDS_BYTES = 147456;

#define GAS __attribute__((address_space(1)))
#define LAS __attribute__((address_space(3)))
typedef unsigned short bf16;
typedef unsigned v4u __attribute__((ext_vector_type(4)));
typedef unsigned v2u __attribute__((ext_vector_type(2)));
typedef float f32x4 __attribute__((ext_vector_type(4)));
typedef short bf16x8 __attribute__((ext_vector_type(8)));
typedef GAS unsigned gu32;
#define RLX_AGENT __ATOMIC_RELAXED, __HIP_MEMORY_SCOPE_AGENT
#define LDS_WAIT() asm volatile("s_waitcnt lgkmcnt(0)" ::: "memory")
#define VM_WAIT() asm volatile("s_waitcnt vmcnt(0)" ::: "memory")
__device__ __forceinline__ unsigned pk2(float lo, float hi) { return pg8::cvt_pk_bf16(lo, hi); }
__device__ __forceinline__ float bf_lo(unsigned w) { return __uint_as_float(w << 16); }
__device__ __forceinline__ float bf_hi(unsigned w) { return __uint_as_float(w & 0xffff0000u); }
__device__ __forceinline__ float ld_agent_f32(const float* p) { return __uint_as_float(__hip_atomic_load((const unsigned*)p, RLX_AGENT)); }

#define XB_TMO      128
#define XB_XCNT(j)  (256  + 64 * (j))
#define XB_XSUB(j)  (1280 + 64 * (j))
#define XB_XGEN(j)  (2304 + 64 * (j))
#define XB_TOP      3328
#define XB_TOPGEN   3392
#define XCD_BAR_WORDS 3456
#define XB_SPIN_CAP (1u << 18)
__device__ __forceinline__ unsigned xb_ld(unsigned* p)              { return __hip_atomic_load(p, __ATOMIC_RELAXED, __HIP_MEMORY_SCOPE_AGENT); }
__device__ __forceinline__ unsigned xb_add(unsigned* p, unsigned v) { return __hip_atomic_fetch_add(p, v, __ATOMIC_RELAXED, __HIP_MEMORY_SCOPE_AGENT); }
__device__ __forceinline__ unsigned xb_xcc_id() { return (unsigned)__builtin_amdgcn_s_getreg((3 << 11) | 20) & 0xFu; }
#define XB_SPIN(cond, bar) do { unsigned _sp = 0; while (cond) { __builtin_amdgcn_s_sleep(1); \
    if ((++_sp & 255u) == 0u) { if (xb_ld(&(bar)[XB_TMO])) break; if (_sp > XB_SPIN_CAP) { atomicAdd(&(bar)[XB_TMO], 1u); break; } } } } while (0)
struct XcdBarrier { unsigned* bar; unsigned x; volatile LAS unsigned* st; };
__device__ __forceinline__ XcdBarrier xcd_barrier_post(unsigned* bar, volatile LAS unsigned* st) {
    XcdBarrier b; b.bar = bar; b.x = xb_xcc_id(); b.st = st;
    if (threadIdx.x == 0) (void)xb_add(&bar[XB_XCNT(b.x)], 1u);
    return b;
}
__device__ __forceinline__ void xcd_barrier_complete(unsigned* bar, unsigned x, unsigned& nloc, unsigned& nx) {
    const unsigned G = gridDim.x * gridDim.y * gridDim.z;
    unsigned sum, cnt, mine, sp = 0u;
    for (;;) {
        sum = 0u; cnt = 0u; mine = 0u;
#pragma unroll
        for (unsigned j = 0; j < 16; ++j) { const unsigned c = xb_ld(&bar[XB_XCNT(j)]); sum += c; cnt += (c > 0u) ? 1u : 0u; mine = (j == x) ? c : mine; }
        if (sum == G) break;
        __builtin_amdgcn_s_sleep(1);
        if ((++sp & 255u) == 0u) { if (xb_ld(&bar[XB_TMO])) break; if (sp > XB_SPIN_CAP) { atomicAdd(&bar[XB_TMO], 1u); break; } }
    }
    nloc = mine > 0u ? mine : 1u; nx = cnt > 0u ? cnt : 1u;
}
__device__ __forceinline__ void xcd_barrier(const XcdBarrier& b) {
    asm volatile("s_waitcnt vmcnt(0)" ::: "memory");
    __syncthreads();
    if (threadIdx.x == 0) {
        unsigned* bar = b.bar;
        __builtin_amdgcn_s_waitcnt(0);
        unsigned nloc = b.st[0], nx = b.st[1];
        if (nloc == 0u) { xcd_barrier_complete(bar, b.x, nloc, nx); b.st[0] = nloc; b.st[1] = nx; }
        const unsigned old = xb_add(&bar[XB_XSUB(b.x)], 1u);
        const unsigned gen = old / nloc;
        if (old + 1u == (gen + 1u) * nloc) {
            __builtin_amdgcn_fence(__ATOMIC_RELEASE, "agent");
            asm volatile("s_waitcnt vmcnt(0)" ::: "memory");
            const unsigned og = xb_add(&bar[XB_TOP], 1u);
            const unsigned tg = og / nx;
            if (og + 1u == (tg + 1u) * nx) xb_add(&bar[XB_TOPGEN], 1u);
            else XB_SPIN(xb_ld(&bar[XB_TOPGEN]) == tg, bar);
            __builtin_amdgcn_fence(__ATOMIC_ACQUIRE, "agent");
            xb_add(&bar[XB_XGEN(b.x)], 1u);
            asm volatile("s_waitcnt vmcnt(0)" ::: "memory");
        } else {
            XB_SPIN(xb_ld(&bar[XB_XGEN(b.x)]) == gen, bar);
            __builtin_amdgcn_fence(__ATOMIC_ACQUIRE, "agent");
            asm volatile("s_waitcnt vmcnt(0)" ::: "memory");
        }
    }
    __syncthreads();
}

enum { I_XP = 0, I_XS, I_CP, I_CS, I_SRE, I_SIM, I_WC, I_BC, I_GPRE, I_WIN, I_LNG, I_LNB, I_WS, I_BS, I_ARE, I_AIM, I_LOGDT, I_BRE, I_BIM, I_CRE, I_CIM, I_DSKIP, I_WGLU, I_BGLU, I_WOUT, I_GPOST, N_IN };
struct Args { const float* in[N_IN]; float* out; unsigned char* ws; int ph_lo, ph_hi; };
struct Ctx { int tid, lane, wave, vcu, G; LAS unsigned char* lds; };

__device__ __forceinline__ float wave_sum(float v) {
#pragma unroll
    for (int o = 1; o < 64; o <<= 1) v += __shfl_xor(v, o);
    return v;
}

__device__ __forceinline__ double d_exp(double x) {
    const double k = __builtin_rint(x * 1.4426950408889634);
    const double r = (x - k * 0.6931471803691238) - k * 1.9082149292705877e-10;
    double p = 1.0 / 6227020800.0;
    p = p * r + 1.0 / 479001600.0; p = p * r + 1.0 / 39916800.0; p = p * r + 1.0 / 3628800.0; p = p * r + 1.0 / 362880.0; p = p * r + 1.0 / 40320.0;
    p = p * r + 1.0 / 5040.0; p = p * r + 1.0 / 720.0; p = p * r + 1.0 / 120.0; p = p * r + 1.0 / 24.0; p = p * r + 1.0 / 6.0; p = p * r + 0.5; p = p * r + 1.0; p = p * r + 1.0;
    const long long bits = ((long long)k + 1023ll) << 52;
    return p * __longlong_as_double(bits);
}
__device__ __forceinline__ void d_sincos(double th, double& s, double& c) {
    const double n = __builtin_rint(th * 0.63661977236758134);
    const double y = (th - n * 1.57079632673412561417) - n * 6.07710050650619224932e-11;
    const double z = y * y;
    double ps = -1.0 / 1307674368000.0; ps = ps * z + 1.0 / 6227020800.0; ps = ps * z - 1.0 / 39916800.0; ps = ps * z + 1.0 / 362880.0; ps = ps * z - 1.0 / 5040.0; ps = ps * z + 1.0 / 120.0; ps = ps * z - 1.0 / 6.0;
    const double sy = y + y * z * ps;
    double pc = 1.0 / 20922789888000.0; pc = pc * z - 1.0 / 87178291200.0; pc = pc * z + 1.0 / 479001600.0; pc = pc * z - 1.0 / 3628800.0; pc = pc * z + 1.0 / 40320.0; pc = pc * z - 1.0 / 720.0; pc = pc * z + 1.0 / 24.0; pc = pc * z - 0.5;
    const double cy = 1.0 + z * pc;
    const int q = (int)((long long)n & 3ll);
    s = (q == 0) ? sy : (q == 1) ? cy : (q == 2) ? -sy : -cy;
    c = (q == 0) ? cy : (q == 1) ? -sy : (q == 2) ? -cy : sy;
}

__device__ __forceinline__ void p0_transpose_item(const float* W, int K, int N, bf16* WT, LAS float* scr, int item, int lane) {
    const int nblk = N / 32, kb = item / nblk, nb = item % nblk, k0 = 64 * kb, n0 = 32 * nb;
#pragma unroll 8
    for (int i = 0; i < 32; ++i) { const int kk = 2 * i + (lane >> 5); scr[kk * 33 + (lane & 31)] = W[(size_t)(k0 + kk) * N + n0 + (lane & 31)]; }
    LDS_WAIT(); asm volatile("" ::: "memory");
    const int c = lane & 7;
#pragma unroll
    for (int j = 0; j < 4; ++j) { const int n = (lane >> 3) + 8 * j; const LAS float* s = scr + (8 * c) * 33 + n;
        v4u o; o.x = pk2(s[0 * 33], s[1 * 33]); o.y = pk2(s[2 * 33], s[3 * 33]); o.z = pk2(s[4 * 33], s[5 * 33]); o.w = pk2(s[6 * 33], s[7 * 33]);
        *(GAS v4u*)(WT + (size_t)(n0 + n) * K + k0 + 8 * c) = o; }
    LDS_WAIT(); asm volatile("" ::: "memory");
}
__device__ __forceinline__ void p0_prologue(const Args& a, const Ctx& C) {
    unsigned char* ws = a.ws;
    const int gt = C.vcu * 512 + C.tid, NT = C.G * 512;
    { unsigned* SC = (unsigned*)(ws + WS_SC); const float* cp = a.in[I_CP]; const float* cs = a.in[I_CS];
      for (int i = gt; i < 144 * 1024; i += NT) { const int m = i >> 10, k = (i & 1023) * 2; float c0 = 0.f, c1 = 0.f;
          if (m < NBATCH) { c0 = cp[m * DM + k]; c1 = cp[m * DM + k + 1]; } else if (m < NCOND) { c0 = cs[(m - NBATCH) * DM + k]; c1 = cs[(m - NBATCH) * DM + k + 1]; }
          const float s0 = c0 / (1.0f + expf(-c0)), s1 = c1 / (1.0f + expf(-c1));
          SC[i] = (m < NCOND) ? pk2(s0, s1) : 0u; } }
    { float* ABAR = (float*)(ws + WS_S5C + S5C_ABAR); float* A16 = (float*)(ws + WS_S5C + S5C_A16); float* A256 = (float*)(ws + WS_S5C + S5C_A256); bf16* BBAR = (bf16*)(ws + WS_S5C + S5C_BBAR);
      for (int i = gt; i < NG * PST; i += NT) { const int g = i >> 6, p = i & 63;
          const double are = (double)a.in[I_ARE][i], aim = (double)a.in[I_AIM][i], dt = d_exp((double)a.in[I_LOGDT][g]);
          double s, c; d_sincos(dt * aim, s, c); const double mag = d_exp(dt * are), abr = mag * c, abi = mag * s;
          ABAR[2 * i] = (float)abr; ABAR[2 * i + 1] = (float)abi;
          { double s2, c2; d_sincos(16.0 * dt * aim, s2, c2); const double m2 = d_exp(16.0 * dt * are); A16[2 * i] = (float)(m2 * c2); A16[2 * i + 1] = (float)(m2 * s2); }
          { double s2, c2; d_sincos(256.0 * dt * aim, s2, c2); const double m2 = d_exp(256.0 * dt * are); A256[2 * i] = (float)(m2 * c2); A256[2 * i + 1] = (float)(m2 * s2); }
          const double nr = abr - 1.0, ni = abi, den = are * are + aim * aim, cr = (nr * are + ni * aim) / den, ci = (ni * are - nr * aim) / den;
          const float* br = a.in[I_BRE] + (size_t)i * 16; const float* bi = a.in[I_BIM] + (size_t)i * 16;
          bf16* o_re = BBAR + (((size_t)g * 8 + 2 * (p >> 4)) * 16 + (p & 15)) * 16; bf16* o_im = o_re + 256;
#pragma unroll
          for (int ch = 0; ch < 16; ch += 2) { const double b0r = br[ch], b0i = bi[ch], b1r = br[ch + 1], b1i = bi[ch + 1];
              *(unsigned*)(o_re + ch) = pk2((float)(cr * b0r - ci * b0i), (float)(cr * b1r - ci * b1i));
              *(unsigned*)(o_im + ch) = pk2((float)(cr * b0i + ci * b0r), (float)(cr * b1i + ci * b1r)); } } }
    { LAS float* scr = (LAS float*)(C.lds + C.wave * 16384);
      const int gw = C.vcu * NWAVES + C.wave, NGW = C.G * NWAVES;
      constexpr int I_1 = (DM / 64) * (DIN / 32), I_2 = (DM / 64) * (DM / 32);
      for (int it = gw; it < I_1 + I_2; it += NGW) {
          if (it < I_1) p0_transpose_item(a.in[I_WIN], DM, DIN, (bf16*)(ws + WS_WIN), scr, it, C.lane);
          else p0_transpose_item(a.in[I_WOUT], DM, DM, (bf16*)(ws + WS_WOUT), scr, it - I_1, C.lane); } }
}

__device__ __forceinline__ void p1_adaln(const Args& a, const Ctx& C) {
    const float* wc = a.in[I_WC]; const float* bc = a.in[I_BC];
    const bf16* SC = (const bf16*)(a.ws + WS_SC); float* MOD = (float*)(a.ws + WS_MOD);
    LAS float* R = (LAS float*)C.lds;
    LAS bf16* T = (LAS bf16*)(C.lds + 18432 + C.wave * 2304);
    const int lane = C.lane, fr = lane & 15, fq = lane >> 4;
    for (int task = C.vcu; task < 192; task += C.G) {
        const int n0 = 32 * task, kb = 256 * C.wave;
        for (int i = C.tid; i < 144 * 32; i += 512) R[i] = 0.f;
        f32x4 acc[9][2];
#pragma unroll
        for (int mi = 0; mi < 9; ++mi) { acc[mi][0] = (f32x4){0.f, 0.f, 0.f, 0.f}; acc[mi][1] = (f32x4){0.f, 0.f, 0.f, 0.f}; }
        const float* wbase = wc + (size_t)(kb + (lane >> 3)) * 6144 + n0 + (lane & 7) * 4;
        const bf16* abase = SC + (size_t)fr * DM + kb + 8 * fq;
        f32x4 w0[4], w1[4], w2[4];
#pragma unroll
        for (int i = 0; i < 4; ++i) { w0[i] = *(const f32x4*)(wbase + (size_t)(8 * i) * 6144); w1[i] = *(const f32x4*)(wbase + (size_t)(32 + 8 * i) * 6144); }
        __syncthreads();
#pragma unroll 1
        for (int ks = 0; ks < 8; ++ks) {
            { const int kn = (ks + 2 < 8) ? ks + 2 : 7; const float* wp = wbase + (size_t)(32 * kn) * 6144;
#pragma unroll
              for (int i = 0; i < 4; ++i) w2[i] = *(const f32x4*)(wp + (size_t)(8 * i) * 6144); }
            bf16x8 af[9];
            { const bf16* ap = abase + 32 * ks;
#pragma unroll
              for (int mi = 0; mi < 9; ++mi) af[mi] = *(const bf16x8*)(ap + (size_t)(16 * mi) * DM); }
#pragma unroll
            for (int i = 0; i < 4; ++i) { const f32x4 v = w0[i]; v2u w; w.x = pk2(v[0], v[1]); w.y = pk2(v[2], v[3]);
                *(LAS v2u*)(T + ((lane >> 3) + 8 * i) * 36 + (lane & 7) * 4) = w; }
            LDS_WAIT();
            bf16x8 bfr[2];
#pragma unroll
            for (int ni = 0; ni < 2; ++ni)
#pragma unroll
                for (int e = 0; e < 8; ++e) bfr[ni][e] = (short)T[(8 * fq + e) * 36 + 16 * ni + fr];
            LDS_WAIT();
#pragma unroll
            for (int mi = 0; mi < 9; ++mi)
#pragma unroll
                for (int ni = 0; ni < 2; ++ni) acc[mi][ni] = __builtin_amdgcn_mfma_f32_16x16x32_bf16(af[mi], bfr[ni], acc[mi][ni], 0, 0, 0);
#pragma unroll
            for (int i = 0; i < 4; ++i) { w0[i] = w1[i]; w1[i] = w2[i]; }
        }
#pragma unroll
        for (int mi = 0; mi < 9; ++mi)
#pragma unroll
            for (int ni = 0; ni < 2; ++ni)
#pragma unroll
                for (int r = 0; r < 4; ++r) atomicAdd((float*)(R + (16 * mi + 4 * fq + r) * 32 + 16 * ni + fr), acc[mi][ni][r]);
        __syncthreads();
        for (int i = C.tid; i < NCOND * 32; i += 512) { const int m = i >> 5, n = i & 31; MOD[(size_t)m * 6144 + n0 + n] = R[i] + bc[n0 + n]; }
        __syncthreads();
    }
}

__device__ __forceinline__ void p2_prenorm(const Args& a, const Ctx& C) {
    const float* MOD = (const float*)(a.ws + WS_MOD); bf16* H = (bf16*)(a.ws + WS_H); const float* gp = a.in[I_GPRE];
    const int gw = C.vcu * NWAVES + C.wave, NGW = C.G * NWAVES, lane = C.lane;
    for (int r = gw; r < MP; r += NGW) {
        GAS v2u* o8 = (GAS v2u*)(H + (size_t)r * DM) + lane;
        if (r >= MTOK) {
#pragma unroll
            for (int j = 0; j < 8; ++j) o8[64 * j] = (v2u){0u, 0u};
            continue; }
        const float* xrow = (r < NBATCH * SEQ) ? a.in[I_XP] + (size_t)r * DM : a.in[I_XS] + (size_t)(r - NBATCH * SEQ) * DM;
        const int b = (r < NBATCH * SEQ) ? (r >> 11) : NBATCH + (r - NBATCH * SEQ);
        const float* shift = MOD + (size_t)b * 6144; const float* scale = shift + DM;
        f32x4 v[8]; float s = 0.f;
#pragma unroll
        for (int j = 0; j < 8; ++j) { v[j] = ((const f32x4*)xrow)[lane + 64 * j]; s += (v[j][0] * v[j][0] + v[j][1] * v[j][1]) + (v[j][2] * v[j][2] + v[j][3] * v[j][3]); }
        const float rinv = 1.0f / sqrtf(wave_sum(s) * (1.0f / DM) + EPS);
#pragma unroll
        for (int j = 0; j < 8; ++j) { const int c4 = lane + 64 * j; const f32x4 g = ((const f32x4*)gp)[c4], sc = ((const f32x4*)scale)[c4], sh = ((const f32x4*)shift)[c4];
            const f32x4 h = v[j] * rinv * g * (sc + 1.0f) + sh;
            o8[64 * j] = (v2u){pk2(h[0], h[1]), pk2(h[2], h[3])}; }
    }
}

__device__ __forceinline__ bf16x8 pack8(f32x4 lo, f32x4 hi) { v4u w; w.x = pk2(lo[0], lo[1]); w.y = pk2(lo[2], lo[3]); w.z = pk2(hi[0], hi[1]); w.w = pk2(hi[2], hi[3]); return __builtin_bit_cast(bf16x8, w); }
__device__ __forceinline__ bf16x8 pack4z(f32x4 lo) { v4u w; w.x = pk2(lo[0], lo[1]); w.y = pk2(lo[2], lo[3]); w.z = 0u; w.w = 0u; return __builtin_bit_cast(bf16x8, w); }
__device__ __forceinline__ bf16x8 raw4z(v2u x) { v4u w; w.x = x.x; w.y = x.y; w.z = 0u; w.w = 0u; return __builtin_bit_cast(bf16x8, w); }
#define MFMA16(A, B, Cc) __builtin_amdgcn_mfma_f32_16x16x32_bf16((A), (B), (Cc), 0, 0, 0)

struct S5C { f32x4 ar[4], ai[4]; bf16x8 Bf[8], Cf[4], Wv, Wg; f32x4 dsk, bv, bg; };
__device__ __forceinline__ void s5_load_consts(S5C& K, const Args& a, int g, int lane) {
    const int fr = lane & 15, q = lane >> 4;
    const float* ABAR = (const float*)(a.ws + WS_S5C + S5C_ABAR) + (size_t)g * 128;
    const bf16* BBAR = (const bf16*)(a.ws + WS_S5C + S5C_BBAR) + (size_t)g * 2048;
#pragma unroll
    for (int j = 0; j < 4; ++j) { const f32x4 x0 = *(const f32x4*)(ABAR + 2 * (16 * j + 4 * q)), x1 = *(const f32x4*)(ABAR + 2 * (16 * j + 4 * q) + 4);
        K.ar[j] = (f32x4){x0[0], x0[2], x1[0], x1[2]}; K.ai[j] = (f32x4){x0[1], x0[3], x1[1], x1[3]}; }
#pragma unroll
    for (int mt = 0; mt < 8; ++mt) K.Bf[mt] = raw4z(*(const v2u*)(BBAR + (mt * 16 + fr) * 16 + 4 * q));
    const float* cre = a.in[I_CRE] + ((size_t)g * 16 + fr) * 64; const float* cim = a.in[I_CIM] + ((size_t)g * 16 + fr) * 64;
#pragma unroll
    for (int j = 0; j < 4; ++j) { const f32x4 r4 = *(const f32x4*)(cre + 16 * j + 4 * q), i4 = *(const f32x4*)(cim + 16 * j + 4 * q); K.Cf[j] = pack8(r4, -i4); }
    const float* wg = a.in[I_WGLU] + (size_t)g * 512;
    { f32x4 v, gt;
#pragma unroll
      for (int e = 0; e < 4; ++e) { v[e] = wg[(4 * q + e) * 32 + fr]; gt[e] = wg[(4 * q + e) * 32 + 16 + fr]; }
      K.Wv = pack4z(v); K.Wg = pack4z(gt); }
    K.dsk = *(const f32x4*)(a.in[I_DSKIP] + g * 16 + 4 * q);
    K.bv = *(const f32x4*)(a.in[I_BGLU] + g * 32 + 4 * q); K.bg = *(const f32x4*)(a.in[I_BGLU] + g * 32 + 16 + 4 * q);
}
#define S5_UPDATE(K, hre, him, xq) do { const bf16x8 xb_ = raw4z(xq); \
    _Pragma("unroll") for (int j = 0; j < 4; ++j) { const f32x4 cre_ = K.ar[j] * hre[j] - K.ai[j] * him[j], cim_ = K.ar[j] * him[j] + K.ai[j] * hre[j]; \
        hre[j] = MFMA16(K.Bf[2 * j], xb_, cre_); him[j] = MFMA16(K.Bf[2 * j + 1], xb_, cim_); } } while (0)
__device__ __forceinline__ v2u s5_output(const S5C& K, const f32x4 (&hre)[4], const f32x4 (&him)[4], v2u xq, v2u zq) {
    f32x4 y = (f32x4){0.f, 0.f, 0.f, 0.f};
#pragma unroll
    for (int j = 0; j < 4; ++j) y = MFMA16(K.Cf[j], pack8(hre[j], him[j]), y);
    const f32x4 xf = (f32x4){bf_lo(xq.x), bf_hi(xq.x), bf_lo(xq.y), bf_hi(xq.y)};
    y = y + K.dsk * xf;
    const bf16x8 yb = pack4z(y);
    const f32x4 gv = MFMA16(K.Wv, yb, K.bv), gg = MFMA16(K.Wg, yb, K.bg);
    const f32x4 zf = (f32x4){bf_lo(zq.x), bf_hi(zq.x), bf_lo(zq.y), bf_hi(zq.y)};
    f32x4 o;
#pragma unroll
    for (int r = 0; r < 4; ++r) o[r] = gv[r] * __builtin_amdgcn_rcpf(1.0f + __expf(-gg[r])) * zf[r];
    return (v2u){pk2(o[0], o[1]), pk2(o[2], o[3])};
}

__device__ __forceinline__ void s5_prompt_task(const Args& a, const Ctx& C, int b, int g) {
    const bf16* PROJ = (const bf16*)(a.ws + WS_PROJ); bf16* Y = (bf16*)(a.ws + WS_Y);
    LAS unsigned char* XS = C.lds;
    LAS float* SH = (LAS float*)(C.lds + 65536);
    LAS float* TW = (LAS float*)(C.lds + 65536 + 128 * 132 * 4);
    const int lane = C.lane, n = lane & 15, q = lane >> 4, w = C.wave;
    const size_t row0 = (size_t)b * SEQ;
    __syncthreads();
    for (int i = C.tid; i < 4096; i += 512) { const int tok = i >> 1, hf = i & 1;
        *(LAS v4u*)(XS + tok * 32 + hf * 16) = *(const v4u*)(PROJ + (row0 + tok) * DIN + 3072 + g * 16 + hf * 8); }
    S5C K; s5_load_consts(K, a, g, lane);
    __syncthreads();
    const int chunk = 16 * w + n;
    f32x4 hre[4], him[4];
#pragma unroll
    for (int j = 0; j < 4; ++j) { hre[j] = (f32x4){0.f, 0.f, 0.f, 0.f}; him[j] = (f32x4){0.f, 0.f, 0.f, 0.f}; }
    for (int t = 0; t < 16; ++t) { const v2u xq = *(const LAS v2u*)(XS + (16 * chunk + t) * 32 + q * 8); S5_UPDATE(K, hre, him, xq); }
#pragma unroll
    for (int j = 0; j < 4; ++j) { LAS float* d = SH + chunk * 132 + 2 * (16 * j + 4 * q);
        *(LAS f32x4*)d = (f32x4){hre[j][0], him[j][0], hre[j][1], him[j][1]}; *(LAS f32x4*)(d + 4) = (f32x4){hre[j][2], him[j][2], hre[j][3], him[j][3]}; }
    LDS_WAIT();
    { const float* A16 = (const float*)(a.ws + WS_S5C + S5C_A16) + (size_t)g * 128; const float* A256 = (const float*)(a.ws + WS_S5C + S5C_A256) + (size_t)g * 128;
      const float a16r = A16[2 * lane], a16i = A16[2 * lane + 1], a256r = A256[2 * lane], a256i = A256[2 * lane + 1];
      float tr = 0.f, ti = 0.f;
      for (int i = 0; i < 16; ++i) { const float sr = SH[(16 * w + i) * 132 + 2 * lane], si = SH[(16 * w + i) * 132 + 2 * lane + 1];
          const float nr = a16r * tr - a16i * ti + sr, ni = a16r * ti + a16i * tr + si; tr = nr; ti = ni; }
      TW[w * 128 + 2 * lane] = tr; TW[w * 128 + 2 * lane + 1] = ti;
      __syncthreads();
      float hr = 0.f, hi = 0.f;
      for (int v = 0; v < w; ++v) { const float sr = TW[v * 128 + 2 * lane], si = TW[v * 128 + 2 * lane + 1];
          const float nr = a256r * hr - a256i * hi + sr, ni = a256r * hi + a256i * hr + si; hr = nr; hi = ni; }
      for (int i = 0; i < 16; ++i) { LAS float* s = SH + (16 * w + i) * 132 + 2 * lane; const float sr = s[0], si = s[1];
          s[0] = hr; s[1] = hi;
          const float nr = a16r * hr - a16i * hi + sr, ni = a16r * hi + a16i * hr + si; hr = nr; hi = ni; }
      if (w == 7) { a.out[OUT_HPRE + ((size_t)b * NG + g) * PST + lane] = hr; a.out[OUT_HPIM + ((size_t)b * NG + g) * PST + lane] = hi; }
      LDS_WAIT(); }
#pragma unroll
    for (int j = 0; j < 4; ++j) { const LAS float* s = SH + chunk * 132 + 2 * (16 * j + 4 * q); const f32x4 x0 = *(const LAS f32x4*)s, x1 = *(const LAS f32x4*)(s + 4);
        hre[j] = (f32x4){x0[0], x0[2], x1[0], x1[2]}; him[j] = (f32x4){x0[1], x0[3], x1[1], x1[3]}; }
    for (int t = 0; t < 16; ++t) { const int tok = 16 * chunk + t;
        const v2u xq = *(const LAS v2u*)(XS + tok * 32 + q * 8);
        const v2u zq = *(const v2u*)(PROJ + (row0 + tok) * DIN + 4096 + g * 16 + 4 * q);
        S5_UPDATE(K, hre, him, xq);
        *(v2u*)(Y + (row0 + tok) * DM + DA + g * 16 + 4 * q) = s5_output(K, hre, him, xq, zq); }
}
__device__ __forceinline__ void s5_sample_task(const Args& a, int rb, int g, int lane) {
    const bf16* PROJ = (const bf16*)(a.ws + WS_PROJ); bf16* Y = (bf16*)(a.ws + WS_Y);
    const int n = lane & 15, q = lane >> 4, i = 16 * rb + n; const size_t row = (size_t)NBATCH * SEQ + i;
    S5C K; s5_load_consts(K, a, g, lane);
    f32x4 hre[4], him[4];
    const float* sre = a.in[I_SRE] + ((size_t)i * NG + g) * PST; const float* sim = a.in[I_SIM] + ((size_t)i * NG + g) * PST;
#pragma unroll
    for (int j = 0; j < 4; ++j) { hre[j] = *(const f32x4*)(sre + 16 * j + 4 * q); him[j] = *(const f32x4*)(sim + 16 * j + 4 * q); }
    const v2u xq = *(const v2u*)(PROJ + row * DIN + 3072 + g * 16 + 4 * q), zq = *(const v2u*)(PROJ + row * DIN + 4096 + g * 16 + 4 * q);
    S5_UPDATE(K, hre, him, xq);
    float* ore = a.out + OUT_HSRE + ((size_t)i * NG + g) * PST; float* oim = a.out + OUT_HSIM + ((size_t)i * NG + g) * PST;
#pragma unroll
    for (int j = 0; j < 4; ++j) { *(f32x4*)(ore + 16 * j + 4 * q) = hre[j]; *(f32x4*)(oim + 16 * j + 4 * q) = him[j]; }
    *(v2u*)(Y + row * DM + DA + g * 16 + 4 * q) = s5_output(K, hre, him, xq, zq);
}
__device__ __forceinline__ void gmlp_tile(const Args& a, const Ctx& C, int c, int hd) {
    const bf16* PROJ = (const bf16*)(a.ws + WS_PROJ); bf16* Y = (bf16*)(a.ws + WS_Y);
    const float* VST = (const float*)(a.ws + WS_CTL) + CW_VSTAT;
    const int lane = C.lane, fr = lane & 15, q = lane >> 4, w = C.wave;
    const size_t T0 = (size_t)c * 128; const int ch = hd * 128 + 16 * w + fr;
    const float lg = a.in[I_LNG][ch], lb = a.in[I_LNB][ch];
    bf16x8 af[4];
#pragma unroll
    for (int ks = 0; ks < 4; ++ks) { f32x4 lo, hi;
#pragma unroll
        for (int e = 0; e < 8; ++e) { const size_t row = T0 + 32 * ks + 8 * q + e;
            const float s1 = ld_agent_f32(VST + 2 * row), s2 = ld_agent_f32(VST + 2 * row + 1);
            const float mu = s1 * (1.0f / DA), var = s2 * (1.0f / DA) - mu * mu, rs = 1.0f / sqrtf(var + EPS);
            const float v = __uint_as_float((unsigned)PROJ[row * DIN + DA + ch] << 16);
            const float x = (v - mu) * rs * lg + lb; if (e < 4) lo[e] = x; else hi[e - 4] = x; }
        af[ks] = pack8(lo, hi); }
    const float* W = a.in[I_WS] + (size_t)hd * 128 * 128;
    f32x4 acc[8];
#pragma unroll
    for (int nt = 0; nt < 8; ++nt) { acc[nt] = (f32x4){0.f, 0.f, 0.f, 0.f};
        const int t = 16 * nt + fr;
#pragma unroll
        for (int ks = 0; ks <= nt / 2; ++ks) { const int s0 = 32 * ks + 8 * q; f32x4 lo = *(const f32x4*)(W + t * 128 + s0), hi = *(const f32x4*)(W + t * 128 + s0 + 4);
#pragma unroll
            for (int e = 0; e < 4; ++e) { lo[e] = (s0 + e <= t) ? lo[e] : 0.f; hi[e] = (s0 + 4 + e <= t) ? hi[e] : 0.f; }
            acc[nt] = MFMA16(af[ks], pack8(lo, hi), acc[nt]); } }
    const int chs = hd * 128 + 16 * w + 4 * q;
#pragma unroll
    for (int nt = 0; nt < 8; ++nt) { const int t = 16 * nt + fr; const size_t row = T0 + t; const float bs = a.in[I_BS][hd * 128 + t];
        const v2u uq = *(const v2u*)(PROJ + row * DIN + chs), zq = *(const v2u*)(PROJ + row * DIN + 2 * DA + chs);
        const float o0 = bf_lo(uq.x) * (acc[nt][0] + bs) * bf_lo(zq.x), o1 = bf_hi(uq.x) * (acc[nt][1] + bs) * bf_hi(zq.x);
        const float o2 = bf_lo(uq.y) * (acc[nt][2] + bs) * bf_lo(zq.y), o3 = bf_hi(uq.y) * (acc[nt][3] + bs) * bf_hi(zq.y);
        *(v2u*)(Y + row * DM + chs) = (v2u){pk2(o0, o1), pk2(o2, o3)}; }
}
__device__ __forceinline__ void p4_mixers(const Args& a, const Ctx& C) {
    const bf16* PROJ = (const bf16*)(a.ws + WS_PROJ); bf16* Y = (bf16*)(a.ws + WS_Y);
    const float* VST = (const float*)(a.ws + WS_CTL) + CW_VSTAT;
    const int gt = C.vcu * 512 + C.tid, NT = C.G * 512;
    for (int i = gt; i < (MP - MTOK) * DM / 8; i += NT) ((v4u*)(Y + (size_t)MTOK * DM))[i] = (v4u){0u, 0u, 0u, 0u};
    for (int i = gt; i < DEC * DA / 4; i += NT) { const int r = i >> 8, c4 = (i & 255) * 4, hd = c4 >> 7; const size_t row = (size_t)NBATCH * SEQ + r;
        const float s1 = ld_agent_f32(VST + 2 * row), s2 = ld_agent_f32(VST + 2 * row + 1);
        const float mu = s1 * (1.0f / DA), var = s2 * (1.0f / DA) - mu * mu, rs = 1.0f / sqrtf(var + EPS);
        const v2u vq = *(const v2u*)(PROJ + row * DIN + DA + c4), uq = *(const v2u*)(PROJ + row * DIN + c4), zq = *(const v2u*)(PROJ + row * DIN + 2 * DA + c4);
        const f32x4 lg = *(const f32x4*)(a.in[I_LNG] + c4), lb = *(const f32x4*)(a.in[I_LNB] + c4);
        const f32x4 vf = (f32x4){bf_lo(vq.x), bf_hi(vq.x), bf_lo(vq.y), bf_hi(vq.y)}, uf = (f32x4){bf_lo(uq.x), bf_hi(uq.x), bf_lo(uq.y), bf_hi(uq.y)}, zf = (f32x4){bf_lo(zq.x), bf_hi(zq.x), bf_lo(zq.y), bf_hi(zq.y)};
        const f32x4 ln = (vf - mu) * rs * lg + lb;
        *(f32x4*)(a.out + OUT_VS + (size_t)r * DA + c4) = ln;
        const float w00 = a.in[I_WS][(size_t)hd * 128 * 128], bs0 = a.in[I_BS][hd * 128];
        const f32x4 o = uf * (ln * w00 + bs0) * zf;
        *(v2u*)(Y + row * DM + c4) = (v2u){pk2(o[0], o[1]), pk2(o[2], o[3])}; }
    if (C.wave < 2) { for (int wt = C.vcu * 2 + C.wave; wt < 8 * NG; wt += C.G * 2) s5_sample_task(a, wt >> 6, wt & 63, C.lane); }
    for (int tt = C.vcu; tt < 512; tt += C.G) gmlp_tile(a, C, tt >> 3, tt & 7);
    for (int tt = C.vcu; tt < NBATCH * NG; tt += C.G) s5_prompt_task(a, C, tt >> 6, tt & 63);
}

__device__ __forceinline__ void p6_final(const Args& a, const Ctx& C) {
    const float* MOD = (const float*)(a.ws + WS_MOD); const bf16* O = (const bf16*)(a.ws + WS_O); const float* OSQ = (const float*)(a.ws + WS_CTL) + CW_OSQ; const float* gpost = a.in[I_GPOST];
    const int gw = C.vcu * NWAVES + C.wave, NGW = C.G * NWAVES, lane = C.lane;
    for (int r = gw; r < MTOK; r += NGW) {
        const float* xrow = (r < NBATCH * SEQ) ? a.in[I_XP] + (size_t)r * DM : a.in[I_XS] + (size_t)(r - NBATCH * SEQ) * DM;
        const int b = (r < NBATCH * SEQ) ? (r >> 11) : NBATCH + (r - NBATCH * SEQ);
        const float* gate = MOD + (size_t)b * 6144 + 2 * DM;
        const float rinv = 1.0f / sqrtf(ld_agent_f32(OSQ + r) * (1.0f / DM) + EPS);
        const v4u* orow = (const v4u*)(O + (size_t)r * DM); float* outr = a.out + (size_t)r * DM;
#pragma unroll
        for (int j = 0; j < 4; ++j) { const int c8 = lane + 64 * j; const v4u ov = orow[c8];
            const f32x4 x0 = ((const f32x4*)xrow)[2 * c8], x1 = ((const f32x4*)xrow)[2 * c8 + 1], g0 = ((const f32x4*)gate)[2 * c8], g1 = ((const f32x4*)gate)[2 * c8 + 1], p0 = ((const f32x4*)gpost)[2 * c8], p1 = ((const f32x4*)gpost)[2 * c8 + 1];
            const f32x4 o0 = (f32x4){bf_lo(ov.x), bf_hi(ov.x), bf_lo(ov.y), bf_hi(ov.y)}, o1 = (f32x4){bf_lo(ov.z), bf_hi(ov.z), bf_lo(ov.w), bf_hi(ov.w)};
            ((f32x4*)outr)[2 * c8] = x0 + g0 * (o0 * rinv * p0); ((f32x4*)outr)[2 * c8 + 1] = x1 + g1 * (o1 * rinv * p1); }
    }
}

__global__ void __launch_bounds__(NWAVES * 64, 2) hymba_fwd(Args args) {
    extern __shared__ __attribute__((aligned(16))) unsigned char lds_raw[];
    Ctx C; C.lds = (LAS unsigned char*)lds_raw;
    C.tid = threadIdx.x; C.lane = C.tid & 63; C.wave = __builtin_amdgcn_readfirstlane(C.tid >> 6);
    C.G = gridDim.x; { const int bx = blockIdx.x; C.vcu = (C.G % 8 == 0) ? (bx % 8) * (C.G / 8) + bx / 8 : bx; }
    gu32* ctl = (gu32*)(args.ws + WS_CTL);
    volatile LAS unsigned* MISC = (volatile LAS unsigned*)(C.lds + MISC_OFF);
    for (int u = C.tid; u < (LDS_BYTES - LDSCTL_OFF) / 4; u += NWAVES * 64) ((LAS unsigned*)(C.lds + LDSCTL_OFF))[u] = 0u;
    __syncthreads();
    XcdBarrier bar; bar.bar = (unsigned*)(ctl + CW_BAR); bar.x = 0; bar.st = nullptr;
    if (N_LAUNCHES != PER_PHASE) bar = xcd_barrier_post((unsigned*)(ctl + CW_BAR), MISC + 8);
    const int lo = args.ph_lo, hi = args.ph_hi;
#define IN(k) (lo <= (k) && (k) < hi)
#define SEAM(k) do { if (IN(k) && IN((k) + 1)) xcd_barrier(bar); } while (0)
    if (IN(0)) { p0_prologue(args, C); SEAM(0); }
    if (IN(1)) { p1_adaln(args, C); SEAM(1); }
    if (IN(2)) { p2_prenorm(args, C); SEAM(2); }
    if (IN(3)) {
        pg8::Gemm g{(const bf16*)(args.ws + WS_H), (const bf16*)(args.ws + WS_WIN), MP, DIN, DM}; pg8::StaticOrder S; S.init(MP, DIN, C.G, (int)blockIdx.x);
        pg8::EpiProj E{(bf16*)(args.ws + WS_PROJ), (float*)(args.ws + WS_CTL) + CW_VSTAT};
        pg8::gemm_phase<pg8::EpiProj, pg8::StaticOrder, true, true>(C.lds, g, S, E);
        SEAM(3);
    }
    if (IN(4)) { p4_mixers(args, C); SEAM(4); }
    if (IN(5)) {
        pg8::Gemm g{(const bf16*)(args.ws + WS_Y), (const bf16*)(args.ws + WS_WOUT), MP, DM, DM}; pg8::StaticOrder S; S.init(MP, DM, C.G, (int)blockIdx.x);
        pg8::EpiO E{(bf16*)(args.ws + WS_O), (float*)(args.ws + WS_CTL) + CW_OSQ};
        pg8::gemm_phase<pg8::EpiO, pg8::StaticOrder, true, true>(C.lds, g, S, E);
        SEAM(5);
    }
    if (IN(6)) { p6_final(args, C); }
#undef IN
#undef SEAM
}

extern "C" void kernel_launch(void* const* d_in, const int* in_sizes, int n_in, void* d_out, int out_size, void* d_ws, size_t ws_size, hipStream_t stream) {
    static int grid = 0;
    if (grid == 0) {
        if (n_in != N_IN || ws_size < WS_END) { fprintf(stderr, "kernel_launch: built for %d inputs and >= %zu bytes of workspace; got %d, %zu\n", (int)N_IN, (size_t)WS_END, n_in, ws_size); grid = -1; return; }
        int dev = 0, cus = 0, per_cu = 0;
        if (hipGetDevice(&dev) != hipSuccess || hipDeviceGetAttribute(&cus, hipDeviceAttributeMultiprocessorCount, dev) != hipSuccess) { grid = -1; return; }
        if (hipFuncSetAttribute((const void*)hymba_fwd, hipFuncAttributeMaxDynamicSharedMemorySize, LDS_BYTES) != hipSuccess) { fprintf(stderr, "kernel_launch: hipFuncSetAttribute failed\n"); grid = -1; return; }
        if (hipOccupancyMaxActiveBlocksPerMultiprocessor(&per_cu, (const void*)hymba_fwd, NWAVES * 64, LDS_BYTES) != hipSuccess || per_cu < 1) { fprintf(stderr, "kernel_launch: occupancy query reports %d workgroups per CU\n", per_cu); }
        (void)hipGetLastError();
        grid = cus;
    }
    if (grid < 0) return;
    if (hipMemsetAsync((char*)d_ws + WS_CTL, 0, CTL_ZERO_BYTES, stream) != hipSuccess) return;
    Args a{};
    for (int i = 0; i < N_IN; ++i) a.in[i] = (const float*)d_in[i];
    a.out = (float*)d_out; a.ws = (unsigned char*)d_ws;
    if (N_LAUNCHES == 1) { a.ph_lo = 0; a.ph_hi = PER_PHASE; hipLaunchKernelGGL(hymba_fwd, dim3(grid), dim3(NWAVES * 64), LDS_BYTES, stream, a); }
    else { for (int li = 0; li < PER_PHASE; ++li) { a.ph_lo = li; a.ph_hi = li + 1; hipLaunchKernelGGL(hymba_fwd, dim3(grid), dim3(NWAVES * 64), LDS_BYTES, stream, a); } }
}
```

```cpp
#include <hip/hip_runtime.h>
#include <cstdio>
#include <cstdint>

#ifndef MK_N_LAUNCHES
#define MK_N_LAUNCHES 1
#endif

namespace pg8 {
#define PG8_LAS __attribute__((address_space(3)))
typedef unsigned short bf16_t;
typedef short bf16x8 __attribute__((ext_vector_type(8)));
typedef float f32x4 __attribute__((ext_vector_type(4)));
typedef unsigned u32x4 __attribute__((ext_vector_type(4)));
constexpr int BM = 256, BK = 64, HALF = 128, HTB = HALF * BK * 2  , STAGE_BYTES = 8 * HTB, NXCD = 8, WGM = 8;

__host__ __device__ __forceinline__ int lds_byte(int r, int c) { const int st = (r >> 4) * 2 + (c >> 5), rr = r & 15, cc = c & 31, ob = rr * 64 + cc * 2; return st * 1024 + (ob ^ (((ob >> 9) & 1) << 5)); }
__host__ __device__ __forceinline__ void stage_rc(int b, int& R, int& C) { const int st = b / 1024, sb = b % 1024, swz = sb ^ (((sb >> 9) & 1) << 5); R = (st >> 1) * 16 + swz / 64; C = (st & 1) * 32 + (swz % 64) / 2; }
__host__ __device__ __forceinline__ int perm32(int rho) { const int n = rho >> 4, i = rho & 15; return 8 * (i >> 2) + 4 * n + (i & 3); }

struct Unit { int pm, pn; };
struct Gemm { const bf16_t* A; const bf16_t* Bt; int M, N, K; };

struct StaticOrder {
    int nM, nN, nwg, G, c;
    __host__ __device__ void init(int M, int N, int G_, int c_) { nM = M / BM; nN = N / BM; nwg = nM * nN; G = G_; c = c_; }
    __host__ __device__ bool next(int i, Unit& u) const {
        const long L = (long)i * G + c; if (L >= nwg) return false;
        int wgid = (int)L; { const int q = nwg / NXCD, r = nwg % NXCD, xcd = wgid % NXCD, off = wgid / NXCD; wgid = (xcd < r ? xcd * (q + 1) : r * (q + 1) + (xcd - r) * q) + off; }
        const int nig = WGM * nN, gid = wgid / nig, fm = gid * WGM, gsz = (nM - fm) < WGM ? (nM - fm) : WGM;
        u.pm = fm + ((wgid % nig) % gsz); u.pn = (wgid % nig) / gsz; return true;
    }
    __device__ __forceinline__ void a_ready(const Unit&) const {}
    __device__ __forceinline__ void done(const Unit&) const {}
};

typedef float f32x2_t __attribute__((ext_vector_type(2)));
typedef __bf16 bf16x2_t __attribute__((ext_vector_type(2)));
__device__ __forceinline__ unsigned cvt_pk_bf16(float lo, float hi) { const f32x2_t v = {lo, hi}; return __builtin_bit_cast(unsigned, __builtin_convertvector(v, bf16x2_t)); }
__device__ __forceinline__ float silu_f(float x) { return x * __builtin_amdgcn_rcpf(1.0f + __expf(-x)); }

struct EpiProj {
    static constexpr bool PERM = true, AFTER_DRAIN = false;
    bf16_t* P; float* vstat;
    __device__ __forceinline__ void operator()(const f32x4 (&acc)[2][2][4][2], const Unit& u, int wr, int wc, int fr, int fq) const {
        const int row0 = u.pm * BM + wr * 64 + fr, col0 = u.pn * BM + wc * 32 + 8 * fq;
        const int type = u.pn >> 2;
        const bool act = (type == 2) || (type == 4), stat = (type == 1);
#pragma unroll
        for (int ai = 0; ai < 2; ++ai)
#pragma unroll
            for (int m = 0; m < 4; ++m) { const int row = row0 + ai * HALF + m * 16; bf16_t* rowp = P + (size_t)row * 5120 + col0; float s1 = 0.f, s2 = 0.f;
#pragma unroll
                for (int bj = 0; bj < 2; ++bj) { f32x4 v0 = acc[ai][bj][m][0], v1 = acc[ai][bj][m][1];
                    if (act) {
#pragma unroll
                        for (int j = 0; j < 4; ++j) { v0[j] = silu_f(v0[j]); v1[j] = silu_f(v1[j]); } }
                    if (stat) {
#pragma unroll
                        for (int j = 0; j < 4; ++j) { s1 += v0[j] + v1[j]; s2 += v0[j] * v0[j] + v1[j] * v1[j]; } }
                    u32x4 w; w.x = cvt_pk_bf16(v0[0], v0[1]); w.y = cvt_pk_bf16(v0[2], v0[3]); w.z = cvt_pk_bf16(v1[0], v1[1]); w.w = cvt_pk_bf16(v1[2], v1[3]);
                    *(u32x4*)(rowp + bj * HALF) = w; }
                if (stat) { s1 += __shfl_xor(s1, 16); s1 += __shfl_xor(s1, 32); s2 += __shfl_xor(s2, 16); s2 += __shfl_xor(s2, 32);
                    if (fq == 0) { atomicAdd(vstat + 2 * row, s1); atomicAdd(vstat + 2 * row + 1, s2); } } }
    }
};
struct EpiO {
    static constexpr bool PERM = true, AFTER_DRAIN = false;
    bf16_t* O; float* osq;
    __device__ __forceinline__ void operator()(const f32x4 (&acc)[2][2][4][2], const Unit& u, int wr, int wc, int fr, int fq) const {
        const int row0 = u.pm * BM + wr * 64 + fr, col0 = u.pn * BM + wc * 32 + 8 * fq;
#pragma unroll
        for (int ai = 0; ai < 2; ++ai)
#pragma unroll
            for (int m = 0; m < 4; ++m) { const int row = row0 + ai * HALF + m * 16; bf16_t* rowp = O + (size_t)row * 2048 + col0; float s2 = 0.f;
#pragma unroll
                for (int bj = 0; bj < 2; ++bj) { const f32x4 v0 = acc[ai][bj][m][0], v1 = acc[ai][bj][m][1];
#pragma unroll
                    for (int j = 0; j < 4; ++j) s2 += v0[j] * v0[j] + v1[j] * v1[j];
                    u32x4 w; w.x = cvt_pk_bf16(v0[0], v0[1]); w.y = cvt_pk_bf16(v0[2], v0[3]); w.z = cvt_pk_bf16(v1[0], v1[1]); w.w = cvt_pk_bf16(v1[2], v1[3]);
                    *(u32x4*)(rowp + bj * HALF) = w; }
                s2 += __shfl_xor(s2, 16); s2 += __shfl_xor(s2, 32);
                if (fq == 0) atomicAdd(osq + row, s2); }
    }
};

template <class Epi, class Sched, bool ALIGN_EPI = false, bool SP2 = false>
__device__ __forceinline__ void gemm_phase(PG8_LAS unsigned char* lds, const Gemm g, const Sched& S, const Epi& E) {
    const int tid = threadIdx.x, wid = __builtin_amdgcn_readfirstlane(tid >> 6), lane = tid & 63, wr = wid >> 2, wc = wid & 3, fr = lane & 15, fq = lane >> 4;
    const int K = g.K, nt = K / BK;
    unsigned voffA[2], voffB[2];
#pragma unroll
    for (int i = 0; i < 2; ++i) { int R, C; stage_rc(tid * 16 + i * 8192, R, C); const int Rb = Epi::PERM ? ((R & ~31) + perm32(R & 31)) : R;
        voffA[i] = (unsigned)(R * K + C) * 2u; voffB[i] = (unsigned)(Rb * K + C) * 2u; }
    const size_t kstep = (size_t)(BK * 2);
    const size_t hstep = (size_t)HALF * K * 2;
    const size_t tstep = 2 * hstep;
    const unsigned ldsw = (unsigned)wid * 1024u;
    const int aoff = lds_byte(wr * 64 + fr, fq * 8), boff = lds_byte(wc * 32 + fr, fq * 8);
#define PG8_SA(b, h) (((b) * 2 + (h)) * HTB)
#define PG8_SB(b, h) ((4 + (b) * 2 + (h)) * HTB)
#define PG8_STAGE(bufoff, gbase, voff) do { _Pragma("unroll") for (int _i = 0; _i < 2; ++_i) \
        __builtin_amdgcn_global_load_lds((const unsigned*)((const char*)(gbase) + (voff)[_i]), (PG8_LAS unsigned*)(lds + (bufoff) + ldsw + _i * 8192), 16, 0, 0); } while (0)
#define PG8_LDA(dst, b, h) do { _Pragma("unroll") for (int m = 0; m < 4; ++m) _Pragma("unroll") for (int k = 0; k < 2; ++k) dst[m][k] = *(const PG8_LAS bf16x8*)(lds + PG8_SA(b, h) + aoff + m * 2048 + k * 1024); } while (0)
#define PG8_LDB(dst, b, h) do { _Pragma("unroll") for (int n = 0; n < 2; ++n) _Pragma("unroll") for (int k = 0; k < 2; ++k) dst[n][k] = *(const PG8_LAS bf16x8*)(lds + PG8_SB(b, h) + boff + n * 2048 + k * 1024); } while (0)
#define PG8_MMA(ai, bj, At, Bt) do { __builtin_amdgcn_s_setprio(1); _Pragma("unroll") for (int m = 0; m < 4; ++m) _Pragma("unroll") for (int n = 0; n < 2; ++n) _Pragma("unroll") for (int k = 0; k < 2; ++k) \
        acc[ai][bj][m][n] = __builtin_amdgcn_mfma_f32_16x16x32_bf16(Bt[n][k], At[m][k], acc[ai][bj][m][n], 0, 0, 0); __builtin_amdgcn_s_setprio(0); } while (0)
#define PG8_WAIT_V(n) asm volatile("s_waitcnt vmcnt(" #n ")" ::: "memory")
#define PG8_WAIT_L(n) asm volatile("s_waitcnt lgkmcnt(" #n ")" ::: "memory")
#define PG8_BAR __builtin_amdgcn_s_barrier()
#define PG8_SCHED __builtin_amdgcn_sched_barrier(0)
    Unit cur, nxt; int ui = 0;
    if (!S.next(0, cur)) return;
    f32x4 acc[2][2][4][2];
#pragma unroll
    for (int a = 0; a < 2; ++a)
#pragma unroll
        for (int b = 0; b < 2; ++b)
#pragma unroll
            for (int m = 0; m < 4; ++m)
#pragma unroll
                for (int n = 0; n < 2; ++n) acc[a][b][m][n] = (f32x4){0.f, 0.f, 0.f, 0.f};
    bf16x8 At[4][2], B0[2][2], B1[2][2];
    const char* cA = (const char*)g.A + (size_t)cur.pm * tstep; const char* cB = (const char*)g.Bt + (size_t)cur.pn * tstep;
    S.a_ready(cur);
    if constexpr (SP2) {
        PG8_STAGE(PG8_SB(0, 0), cB, voffB); PG8_STAGE(PG8_SB(0, 1), cB + hstep, voffB); PG8_STAGE(PG8_SA(0, 0), cA, voffA); PG8_STAGE(PG8_SA(0, 1), cA + hstep, voffA);
        if (wr == 1) PG8_BAR;
        PG8_WAIT_V(2); PG8_BAR;
        PG8_STAGE(PG8_SB(1, 0), cB + kstep, voffB); PG8_STAGE(PG8_SA(1, 0), cA + kstep, voffA); PG8_STAGE(PG8_SB(1, 1), cB + hstep + kstep, voffB);
        PG8_WAIT_V(6); PG8_BAR;
    } else {
        PG8_STAGE(PG8_SB(0, 0), cB, voffB); PG8_STAGE(PG8_SA(0, 0), cA, voffA); PG8_STAGE(PG8_SB(0, 1), cB + hstep, voffB); PG8_STAGE(PG8_SA(0, 1), cA + hstep, voffA);
        if (wr == 1) PG8_BAR;
        PG8_WAIT_V(4); PG8_BAR;
        PG8_STAGE(PG8_SB(1, 0), cB + kstep, voffB); PG8_STAGE(PG8_SA(1, 0), cA + kstep, voffA); PG8_STAGE(PG8_SB(1, 1), cB + hstep + kstep, voffB);
        PG8_WAIT_V(6); PG8_BAR;
    }
    for (;;) {
        const bool has_next = S.next(ui + 1, nxt);
        const char* nA = has_next ? (const char*)g.A + (size_t)nxt.pm * tstep : cA; const char* nB = has_next ? (const char*)g.Bt + (size_t)nxt.pn * tstep : cB;
        for (int t = 0; t < nt; t += 2) {
            const bool last = (t == nt - 2);
            const char* a1 = cA + (size_t)(t + 1) * kstep;
            const char* a2 = last ? nA : cA + (size_t)(t + 2) * kstep; const char* b2 = last ? nB : cB + (size_t)(t + 2) * kstep;
            const char* a3 = a2 + kstep; const char* b3 = b2 + kstep;
            if (last && has_next) S.a_ready(nxt);
            if constexpr (SP2) {
            PG8_LDB(B0, 0, 0); PG8_LDB(B1, 0, 1); PG8_SCHED; PG8_LDA(At, 0, 0); PG8_STAGE(PG8_SA(1, 1), a1 + hstep, voffA);
            PG8_WAIT_V(8); PG8_WAIT_L(0); PG8_BAR; PG8_MMA(0, 0, At, B0); PG8_MMA(0, 1, At, B1); PG8_BAR; PG8_SCHED;
            PG8_LDA(At, 0, 1); PG8_STAGE(PG8_SB(0, 0), b2, voffB); PG8_STAGE(PG8_SB(0, 1), b2 + hstep, voffB); PG8_STAGE(PG8_SA(0, 0), a2, voffA);
            PG8_WAIT_V(8); PG8_WAIT_L(0); PG8_BAR; PG8_MMA(1, 0, At, B0); PG8_MMA(1, 1, At, B1); PG8_BAR; PG8_SCHED;
            PG8_LDB(B0, 1, 0); PG8_LDB(B1, 1, 1); PG8_SCHED; PG8_LDA(At, 1, 0); PG8_STAGE(PG8_SA(0, 1), a2 + hstep, voffA);
            PG8_WAIT_V(8); PG8_WAIT_L(0); PG8_BAR; PG8_MMA(0, 0, At, B0); PG8_MMA(0, 1, At, B1); PG8_BAR; PG8_SCHED;
            PG8_LDA(At, 1, 1); PG8_STAGE(PG8_SB(1, 0), b3, voffB); PG8_STAGE(PG8_SB(1, 1), b3 + hstep, voffB); PG8_STAGE(PG8_SA(1, 0), a3, voffA);
            PG8_WAIT_V(8); PG8_WAIT_L(0); PG8_BAR; PG8_MMA(1, 0, At, B0); PG8_MMA(1, 1, At, B1); PG8_BAR; PG8_SCHED;
            } else {
            PG8_LDB(B0, 0, 0); PG8_SCHED; PG8_LDA(At, 0, 0); PG8_STAGE(PG8_SA(1, 1), a1 + hstep, voffA);
            PG8_WAIT_L(8); PG8_BAR; PG8_WAIT_L(0); PG8_MMA(0, 0, At, B0); PG8_BAR; PG8_SCHED;
            PG8_LDB(B1, 0, 1); PG8_STAGE(PG8_SB(0, 0), b2, voffB);
            PG8_BAR; PG8_WAIT_L(0); PG8_MMA(0, 1, At, B1); PG8_BAR;
            PG8_LDA(At, 0, 1); PG8_STAGE(PG8_SA(0, 0), a2, voffA);
            PG8_BAR; PG8_WAIT_L(0); PG8_MMA(1, 0, At, B0); PG8_BAR; PG8_SCHED;
            PG8_STAGE(PG8_SB(0, 1), b2 + hstep, voffB);
            PG8_WAIT_V(6); PG8_BAR; PG8_MMA(1, 1, At, B1); PG8_BAR;
            PG8_LDB(B0, 1, 0); PG8_SCHED; PG8_LDA(At, 1, 0); PG8_STAGE(PG8_SA(0, 1), a2 + hstep, voffA);
            PG8_WAIT_L(8); PG8_BAR; PG8_WAIT_L(0); PG8_MMA(0, 0, At, B0); PG8_BAR; PG8_SCHED;
            PG8_LDB(B1, 1, 1); PG8_STAGE(PG8_SB(1, 0), b3, voffB);
            PG8_BAR; PG8_WAIT_L(0); PG8_MMA(0, 1, At, B1); PG8_BAR;
            PG8_LDA(At, 1, 1); PG8_STAGE(PG8_SA(1, 0), a3, voffA);
            PG8_BAR; PG8_WAIT_L(0); PG8_MMA(1, 0, At, B0); PG8_BAR; PG8_SCHED;
            PG8_STAGE(PG8_SB(1, 1), b3 + hstep, voffB);
            PG8_WAIT_V(6); PG8_BAR; PG8_MMA(1, 1, At, B1); PG8_BAR;
            }
        }
        if constexpr (ALIGN_EPI) { if (wr == 0) PG8_BAR; }
        if constexpr (!Epi::AFTER_DRAIN) { E(acc, cur, wr, wc, fr, fq); S.done(cur); }
        if (!has_next) break;
#pragma unroll
        for (int a = 0; a < 2; ++a)
#pragma unroll
            for (int b = 0; b < 2; ++b)
#pragma unroll
                for (int m = 0; m < 4; ++m)
#pragma unroll
                    for (int n = 0; n < 2; ++n) acc[a][b][m][n] = (f32x4){0.f, 0.f, 0.f, 0.f};
        cur = nxt; cA = nA; cB = nB; ++ui;
        if constexpr (ALIGN_EPI) { if (wr == 1) PG8_BAR; }
    }
    PG8_WAIT_V(0);
    if constexpr (!ALIGN_EPI) { if (wr == 0) PG8_BAR; }
    PG8_BAR;
#undef PG8_SA
#undef PG8_SB
#undef PG8_STAGE
#undef PG8_LDA
#undef PG8_LDB
#undef PG8_MMA
#undef PG8_WAIT_V
#undef PG8_WAIT_L
#undef PG8_BAR
#undef PG8_SCHED
}
}

constexpr int NWAVES = 8;
constexpr int N_LAUNCHES = MK_N_LAUNCHES;
constexpr int PER_PHASE = 7;
constexpr int DM = 2048, NBATCH = 4, SEQ = 2048, DEC = 128;
constexpr int MTOK = NBATCH * SEQ + DEC;
constexpr int MP = 8448;
constexpr int DA = 1024, DIN = 5120, NCOND = NBATCH + DEC;
constexpr int NG = 64, PST = 64;
constexpr float EPS = 1e-6f;
constexpr size_t OUT_VS = (size_t)MTOK * DM, OUT_HPRE = OUT_VS + (size_t)DEC * DA, OUT_HPIM = OUT_HPRE + NBATCH * NG * PST,
                 OUT_HSRE = OUT_HPIM + NBATCH * NG * PST, OUT_HSIM = OUT_HSRE + (size_t)DEC * NG * PST;
constexpr size_t MiB = 1u << 20;
constexpr size_t WS_CTL = 0, CTL_ZERO_BYTES = 1 * MiB;
constexpr size_t WS_WIN = 2 * MiB, WS_WOUT = 22 * MiB, WS_SC = 30 * MiB, WS_MOD = 31 * MiB, WS_S5C = 35 * MiB;
constexpr size_t WS_H = 36 * MiB, WS_PROJ = 69 * MiB, WS_Y = 152 * MiB, WS_O = 185 * MiB, WS_END = 218 * MiB;
constexpr size_t S5C_ABAR = 0, S5C_A16 = 32768, S5C_A256 = 65536, S5C_BBAR = 131072;
constexpr int CW_BAR = 4096, CW_VSTAT = 32768, CW_OSQ = 65536;
constexpr int RING_BYTES = 131072, LDSCTL_OFF = 143360, MISC_OFF = LDSCTL_OFF + 320, LDS_BYTES = 147456;

#define GAS __attribute__((address_space(1)))
#define LAS __attribute__((address_space(3)))
typedef unsigned short bf16;
typedef unsigned v4u __attribute__((ext_vector_type(4)));
typedef unsigned v2u __attribute__((ext_vector_type(2)));
typedef float f32x4 __attribute__((ext_vector_type(4)));
typedef short bf16x8 __attribute__((ext_vector_type(8)));
typedef GAS unsigned gu32;
#define RLX_AGENT __ATOMIC_RELAXED, __HIP_MEMORY_SCOPE_AGENT
#define LDS_WAIT() asm volatile("s_waitcnt lgkmcnt(0)" ::: "memory")
#define VM_WAIT() asm volatile("s_waitcnt vmcnt(0)" ::: "memory")
__device__ __forceinline__ unsigned pk2(float lo, float hi) { return pg8::cvt_pk_bf16(lo, hi); }
__device__ __forceinline__ float bf_lo(unsigned w) { return __uint_as_float(w << 16); }
__device__ __forceinline__ float bf_hi(unsigned w) { return __uint_as_float(w & 0xffff0000u); }
__device__ __forceinline__ float ld_agent_f32(const float* p) { return __uint_as_float(__hip_atomic_load((const unsigned*)p, RLX_AGENT)); }

#define XB_TMO      128
#define XB_XCNT(j)  (256  + 64 * (j))
#define XB_XSUB(j)  (1280 + 64 * (j))
#define XB_XGEN(j)  (2304 + 64 * (j))
#define XB_TOP      3328
#define XB_TOPGEN   3392
#define XCD_BAR_WORDS 3456
#define XB_SPIN_CAP (1u << 18)
__device__ __forceinline__ unsigned xb_ld(unsigned* p)              { return __hip_atomic_load(p, __ATOMIC_RELAXED, __HIP_MEMORY_SCOPE_AGENT); }
__device__ __forceinline__ unsigned xb_add(unsigned* p, unsigned v) { return __hip_atomic_fetch_add(p, v, __ATOMIC_RELAXED, __HIP_MEMORY_SCOPE_AGENT); }
__device__ __forceinline__ unsigned xb_xcc_id() { return (unsigned)__builtin_amdgcn_s_getreg((3 << 11) | 20) & 0xFu; }
#define XB_SPIN(cond, bar) do { unsigned _sp = 0; while (cond) { __builtin_amdgcn_s_sleep(1); \
    if ((++_sp & 255u) == 0u) { if (xb_ld(&(bar)[XB_TMO])) break; if (_sp > XB_SPIN_CAP) { atomicAdd(&(bar)[XB_TMO], 1u); break; } } } } while (0)
struct XcdBarrier { unsigned* bar; unsigned x; volatile LAS unsigned* st; };
__device__ __forceinline__ XcdBarrier xcd_barrier_post(unsigned* bar, volatile LAS unsigned* st) {
    XcdBarrier b; b.bar = bar; b.x = xb_xcc_id(); b.st = st;
    if (threadIdx.x == 0) (void)xb_add(&bar[XB_XCNT(b.x)], 1u);
    return b;
}
__device__ __forceinline__ void xcd_barrier_complete(unsigned* bar, unsigned x, unsigned& nloc, unsigned& nx) {
    const unsigned G = gridDim.x * gridDim.y * gridDim.z;
    unsigned sum, cnt, mine, sp = 0u;
    for (;;) {
        sum = 0u; cnt = 0u; mine = 0u;
#pragma unroll
        for (unsigned j = 0; j < 16; ++j) { const unsigned c = xb_ld(&bar[XB_XCNT(j)]); sum += c; cnt += (c > 0u) ? 1u : 0u; mine = (j == x) ? c : mine; }
        if (sum == G) break;
        __builtin_amdgcn_s_sleep(1);
        if ((++sp & 255u) == 0u) { if (xb_ld(&bar[XB_TMO])) break; if (sp > XB_SPIN_CAP) { atomicAdd(&bar[XB_TMO], 1u); break; } }
    }
    nloc = mine > 0u ? mine : 1u; nx = cnt > 0u ? cnt : 1u;
}
__device__ __forceinline__ void xcd_barrier(const XcdBarrier& b) {
    asm volatile("s_waitcnt vmcnt(0)" ::: "memory");
    __syncthreads();
    if (threadIdx.x == 0) {
        unsigned* bar = b.bar;
        __builtin_amdgcn_s_waitcnt(0);
        unsigned nloc = b.st[0], nx = b.st[1];
        if (nloc == 0u) { xcd_barrier_complete(bar, b.x, nloc, nx); b.st[0] = nloc; b.st[1] = nx; }
        const unsigned old = xb_add(&bar[XB_XSUB(b.x)], 1u);
        const unsigned gen = old / nloc;
        if (old + 1u == (gen + 1u) * nloc) {
            __builtin_amdgcn_fence(__ATOMIC_RELEASE, "agent");
            asm volatile("s_waitcnt vmcnt(0)" ::: "memory");
            const unsigned og = xb_add(&bar[XB_TOP], 1u);
            const unsigned tg = og / nx;
            if (og + 1u == (tg + 1u) * nx) xb_add(&bar[XB_TOPGEN], 1u);
            else XB_SPIN(xb_ld(&bar[XB_TOPGEN]) == tg, bar);
            __builtin_amdgcn_fence(__ATOMIC_ACQUIRE, "agent");
            xb_add(&bar[XB_XGEN(b.x)], 1u);
            asm volatile("s_waitcnt vmcnt(0)" ::: "memory");
        } else {
            XB_SPIN(xb_ld(&bar[XB_XGEN(b.x)]) == gen, bar);
            __builtin_amdgcn_fence(__ATOMIC_ACQUIRE, "agent");
            asm volatile("s_waitcnt vmcnt(0)" ::: "memory");
        }
    }
    __syncthreads();
}

enum { I_XP = 0, I_XS, I_CP, I_CS, I_SRE, I_SIM, I_WC, I_BC, I_GPRE, I_WIN, I_LNG, I_LNB, I_WS, I_BS, I_ARE, I_AIM, I_LOGDT, I_BRE, I_BIM, I_CRE, I_CIM, I_DSKIP, I_WGLU, I_BGLU, I_WOUT, I_GPOST, N_IN };
struct Args { const float* in[N_IN]; float* out; unsigned char* ws; int ph_lo, ph_hi; };
struct Ctx { int tid, lane, wave, vcu, G; LAS unsigned char* lds; };

__device__ __forceinline__ float wave_sum(float v) {
#pragma unroll
    for (int o = 1; o < 64; o <<= 1) v += __shfl_xor(v, o);
    return v;
}

__device__ __forceinline__ double d_exp(double x) {
    const double k = __builtin_rint(x * 1.4426950408889634);
    const double r = (x - k * 0.6931471803691238) - k * 1.9082149292705877e-10;
    double p = 1.0 / 6227020800.0;
    p = p * r + 1.0 / 479001600.0; p = p * r + 1.0 / 39916800.0; p = p * r + 1.0 / 3628800.0; p = p * r + 1.0 / 362880.0; p = p * r + 1.0 / 40320.0;
    p = p * r + 1.0 / 5040.0; p = p * r + 1.0 / 720.0; p = p * r + 1.0 / 120.0; p = p * r + 1.0 / 24.0; p = p * r + 1.0 / 6.0; p = p * r + 0.5; p = p * r + 1.0; p = p * r + 1.0;
    const long long bits = ((long long)k + 1023ll) << 52;
    return p * __longlong_as_double(bits);
}
__device__ __forceinline__ void d_sincos(double th, double& s, double& c) {
    const double n = __builtin_rint(th * 0.63661977236758134);
    const double y = (th - n * 1.57079632673412561417) - n * 6.07710050650619224932e-11;
    const double z = y * y;
    double ps = -1.0 / 1307674368000.0; ps = ps * z + 1.0 / 6227020800.0; ps = ps * z - 1.0 / 39916800.0; ps = ps * z + 1.0 / 362880.0; ps = ps * z - 1.0 / 5040.0; ps = ps * z + 1.0 / 120.0; ps = ps * z - 1.0 / 6.0;
    const double sy = y + y * z * ps;
    double pc = 1.0 / 20922789888000.0; pc = pc * z - 1.0 / 87178291200.0; pc = pc * z + 1.0 / 479001600.0; pc = pc * z - 1.0 / 3628800.0; pc = pc * z + 1.0 / 40320.0; pc = pc * z - 1.0 / 720.0; pc = pc * z + 1.0 / 24.0; pc = pc * z - 0.5;
    const double cy = 1.0 + z * pc;
    const int q = (int)((long long)n & 3ll);
    s = (q == 0) ? sy : (q == 1) ? cy : (q == 2) ? -sy : -cy;
    c = (q == 0) ? cy : (q == 1) ? -sy : (q == 2) ? -cy : sy;
}

__device__ __forceinline__ void p0_transpose_item(const float* W, int K, int N, bf16* WT, LAS float* scr, int item, int lane) {
    const int nblk = N / 32, kb = item / nblk, nb = item % nblk, k0 = 64 * kb, n0 = 32 * nb;
#pragma unroll 8
    for (int i = 0; i < 32; ++i) { const int kk = 2 * i + (lane >> 5); scr[kk * 33 + (lane & 31)] = W[(size_t)(k0 + kk) * N + n0 + (lane & 31)]; }
    LDS_WAIT(); asm volatile("" ::: "memory");
    const int c = lane & 7;
#pragma unroll
    for (int j = 0; j < 4; ++j) { const int n = (lane >> 3) + 8 * j; const LAS float* s = scr + (8 * c) * 33 + n;
        v4u o; o.x = pk2(s[0 * 33], s[1 * 33]); o.y = pk2(s[2 * 33], s[3 * 33]); o.z = pk2(s[4 * 33], s[5 * 33]); o.w = pk2(s[6 * 33], s[7 * 33]);
        *(GAS v4u*)(WT + (size_t)(n0 + n) * K + k0 + 8 * c) = o; }
    LDS_WAIT(); asm volatile("" ::: "memory");
}
__device__ __forceinline__ void p0_prologue(const Args& a, const Ctx& C) {
    unsigned char* ws = a.ws;
    const int gt = C.vcu * 512 + C.tid, NT = C.G * 512;
    { unsigned* SC = (unsigned*)(ws + WS_SC); const float* cp = a.in[I_CP]; const float* cs = a.in[I_CS];
      for (int i = gt; i < 144 * 1024; i += NT) { const int m = i >> 10, k = (i & 1023) * 2; float c0 = 0.f, c1 = 0.f;
          if (m < NBATCH) { c0 = cp[m * DM + k]; c1 = cp[m * DM + k + 1]; } else if (m < NCOND) { c0 = cs[(m - NBATCH) * DM + k]; c1 = cs[(m - NBATCH) * DM + k + 1]; }
          const float s0 = c0 / (1.0f + expf(-c0)), s1 = c1 / (1.0f + expf(-c1));
          SC[i] = (m < NCOND) ? pk2(s0, s1) : 0u; } }
    { float* ABAR = (float*)(ws + WS_S5C + S5C_ABAR); float* A16 = (float*)(ws + WS_S5C + S5C_A16); float* A256 = (float*)(ws + WS_S5C + S5C_A256); bf16* BBAR = (bf16*)(ws + WS_S5C + S5C_BBAR);
      for (int i = gt; i < NG * PST; i += NT) { const int g = i >> 6, p = i & 63;
          const double are = (double)a.in[I_ARE][i], aim = (double)a.in[I_AIM][i], dt = d_exp((double)a.in[I_LOGDT][g]);
          double s, c; d_sincos(dt * aim, s, c); const double mag = d_exp(dt * are), abr = mag * c, abi = mag * s;
          ABAR[2 * i] = (float)abr; ABAR[2 * i + 1] = (float)abi;
          { double s2, c2; d_sincos(16.0 * dt * aim, s2, c2); const double m2 = d_exp(16.0 * dt * are); A16[2 * i] = (float)(m2 * c2); A16[2 * i + 1] = (float)(m2 * s2); }
          { double s2, c2; d_sincos(256.0 * dt * aim, s2, c2); const double m2 = d_exp(256.0 * dt * are); A256[2 * i] = (float)(m2 * c2); A256[2 * i + 1] = (float)(m2 * s2); }
          const double nr = abr - 1.0, ni = abi, den = are * are + aim * aim, cr = (nr * are + ni * aim) / den, ci = (ni * are - nr * aim) / den;
          const float* br = a.in[I_BRE] + (size_t)i * 16; const float* bi = a.in[I_BIM] + (size_t)i * 16;
          bf16* o_re = BBAR + (((size_t)g * 8 + 2 * (p >> 4)) * 16 + (p & 15)) * 16; bf16* o_im = o_re + 256;
#pragma unroll
          for (int ch = 0; ch < 16; ch += 2) { const double b0r = br[ch], b0i = bi[ch], b1r = br[ch + 1], b1i = bi[ch + 1];
              *(unsigned*)(o_re + ch) = pk2((float)(cr * b0r - ci * b0i), (float)(cr * b1r - ci * b1i));
              *(unsigned*)(o_im + ch) = pk2((float)(cr * b0i + ci * b0r), (float)(cr * b1i + ci * b1r)); } } }
    { LAS float* scr = (LAS float*)(C.lds + C.wave * 16384);
      const int gw = C.vcu * NWAVES + C.wave, NGW = C.G * NWAVES;
      constexpr int I_1 = (DM / 64) * (DIN / 32), I_2 = (DM / 64) * (DM / 32);
      for (int it = gw; it < I_1 + I_2; it += NGW) {
          if (it < I_1) p0_transpose_item(a.in[I_WIN], DM, DIN, (bf16*)(ws + WS_WIN), scr, it, C.lane);
          else p0_transpose_item(a.in[I_WOUT], DM, DM, (bf16*)(ws + WS_WOUT), scr, it - I_1, C.lane); } }
}

__device__ __forceinline__ void p1_adaln(const Args& a, const Ctx& C) {
    const float* wc = a.in[I_WC]; const float* bc = a.in[I_BC];
    const bf16* SC = (const bf16*)(a.ws + WS_SC); float* MOD = (float*)(a.ws + WS_MOD);
    LAS bf16* T = (LAS bf16*)(C.lds + 18432 + C.wave * 2304);
    const int lane = C.lane, fr = lane & 15, fq = lane >> 4;
    for (int task = C.vcu; task < 192; task += C.G) {
        const int n0 = 32 * task, kb = 256 * C.wave;
        f32x4 acc[9][2];
#pragma unroll
        for (int mi = 0; mi < 9; ++mi) { acc[mi][0] = (f32x4){0.f, 0.f, 0.f, 0.f}; acc[mi][1] = (f32x4){0.f, 0.f, 0.f, 0.f}; }
        const char* wu = (const char*)(wc + (size_t)kb * 6144 + n0);
        const unsigned wvo = (unsigned)(((lane >> 3) * 6144 + (lane & 7) * 4) * 4);
        const char* au = (const char*)(SC + kb);
        const unsigned avo = (unsigned)((fr * DM + 8 * fq) * 2);
#define P1_LDW(dst, s_) do { const int s__ = (s_) < 8 ? (s_) : 7; _Pragma("unroll") for (int i = 0; i < 4; ++i) dst[i] = *(const f32x4*)(wu + (size_t)(32 * s__ + 8 * i) * 24576 + wvo); } while (0)
#define P1_LDA(dst, s_) do { const int s__ = (s_) < 8 ? (s_) : 7; _Pragma("unroll") for (int mi = 0; mi < 9; ++mi) dst[mi] = *(const bf16x8*)(au + (size_t)(16 * mi) * (DM * 2) + 64 * s__ + avo); } while (0)
#define P1_STEP(wcur, acur) do { \
            _Pragma("unroll") for (int i = 0; i < 4; ++i) { const f32x4 v = wcur[i]; v2u w; w.x = pk2(v[0], v[1]); w.y = pk2(v[2], v[3]); \
                *(LAS v2u*)(T + ((lane >> 3) + 8 * i) * 36 + (lane & 7) * 4) = w; } \
            LDS_WAIT(); \
            bf16x8 bfr[2]; \
            _Pragma("unroll") for (int ni = 0; ni < 2; ++ni) _Pragma("unroll") for (int e = 0; e < 8; ++e) bfr[ni][e] = (short)T[(8 * fq + e) * 36 + 16 * ni + fr]; \
            LDS_WAIT(); \
            _Pragma("unroll") for (int mi = 0; mi < 9; ++mi) _Pragma("unroll") for (int ni = 0; ni < 2; ++ni) acc[mi][ni] = __builtin_amdgcn_mfma_f32_16x16x32_bf16(acur[mi], bfr[ni], acc[mi][ni], 0, 0, 0); } while (0)
        f32x4 w0[4], w1[4], w2[4], w3[4]; bf16x8 a0[9];
        P1_LDW(w0, 0); P1_LDW(w1, 1); P1_LDW(w2, 2);
        __syncthreads();
#pragma unroll 1
        for (int o = 0; o < 8; o += 4) {
            P1_LDA(a0, o);     P1_LDW(w3, o + 3); P1_STEP(w0, a0);
            P1_LDA(a0, o + 1); P1_LDW(w0, o + 4); P1_STEP(w1, a0);
            P1_LDA(a0, o + 2); P1_LDW(w1, o + 5); P1_STEP(w2, a0);
            P1_LDA(a0, o + 3); P1_LDW(w2, o + 6); P1_STEP(w3, a0);
        }
#undef P1_LDW
#undef P1_LDA
#undef P1_STEP
        LAS f32x4* SL = (LAS f32x4*)(C.lds + 40960);
#pragma unroll
        for (int hf = 0; hf < 2; ++hf) { const int m0 = hf * 5, nm = hf ? 4 : 5;
#pragma unroll
            for (int ml = 0; ml < 5; ++ml) if (ml < nm) { SL[((C.wave * 5 + ml) * 2 + 0) * 64 + lane] = acc[m0 + ml][0]; SL[((C.wave * 5 + ml) * 2 + 1) * 64 + lane] = acc[m0 + ml][1]; }
            __syncthreads();
            for (int it = C.tid; it < nm * 128; it += 512) { const int ml = it >> 7, ni = (it >> 6) & 1, ln = it & 63; f32x4 sum = SL[((0 * 5 + ml) * 2 + ni) * 64 + ln];
#pragma unroll
                for (int w = 1; w < 8; ++w) sum += SL[((w * 5 + ml) * 2 + ni) * 64 + ln];
                const int n = n0 + 16 * ni + (ln & 15), mrow = 16 * (m0 + ml) + 4 * (ln >> 4); const float bias = bc[n];
#pragma unroll
                for (int r = 0; r < 4; ++r) if (mrow + r < NCOND) MOD[(size_t)(mrow + r) * 6144 + n] = sum[r] + bias; }
            __syncthreads(); }
    }
}

__device__ __forceinline__ void p2_prenorm(const Args& a, const Ctx& C) {
    const float* MOD = (const float*)(a.ws + WS_MOD); bf16* H = (bf16*)(a.ws + WS_H); const float* gp = a.in[I_GPRE];
    const int gw = C.vcu * NWAVES + C.wave, NGW = C.G * NWAVES, lane = C.lane;
    for (int r = gw; r < MP; r += NGW) {
        GAS v2u* o8 = (GAS v2u*)(H + (size_t)r * DM) + lane;
        if (r >= MTOK) {
#pragma unroll
            for (int j = 0; j < 8; ++j) o8[64 * j] = (v2u){0u, 0u};
            continue; }
        const float* xrow = (r < NBATCH * SEQ) ? a.in[I_XP] + (size_t)r * DM : a.in[I_XS] + (size_t)(r - NBATCH * SEQ) * DM;
        const int b = (r < NBATCH * SEQ) ? (r >> 11) : NBATCH + (r - NBATCH * SEQ);
        const float* shift = MOD + (size_t)b * 6144; const float* scale = shift + DM;
        f32x4 v[8]; float s = 0.f;
#pragma unroll
        for (int j = 0; j < 8; ++j) { v[j] = ((const f32x4*)xrow)[lane + 64 * j]; s += (v[j][0] * v[j][0] + v[j][1] * v[j][1]) + (v[j][2] * v[j][2] + v[j][3] * v[j][3]); }
        const float rinv = __builtin_amdgcn_rsqf(wave_sum(s) * (1.0f / DM) + EPS);
#pragma unroll
        for (int j = 0; j < 8; ++j) { const int c4 = lane + 64 * j; const f32x4 g = ((const f32x4*)gp)[c4], sc = ((const f32x4*)scale)[c4], sh = ((const f32x4*)shift)[c4];
            const f32x4 h = v[j] * rinv * g * (sc + 1.0f) + sh;
            o8[64 * j] = (v2u){pk2(h[0], h[1]), pk2(h[2], h[3])}; }
    }
}

__device__ __forceinline__ bf16x8 pack8(f32x4 lo, f32x4 hi) { v4u w; w.x = pk2(lo[0], lo[1]); w.y = pk2(lo[2], lo[3]); w.z = pk2(hi[0], hi[1]); w.w = pk2(hi[2], hi[3]); return __builtin_bit_cast(bf16x8, w); }
__device__ __forceinline__ bf16x8 pack4z(f32x4 lo) { v4u w; w.x = pk2(lo[0], lo[1]); w.y = pk2(lo[2], lo[3]); w.z = 0u; w.w = 0u; return __builtin_bit_cast(bf16x8, w); }
__device__ __forceinline__ bf16x8 raw4z(v2u x) { v4u w; w.x = x.x; w.y = x.y; w.z = 0u; w.w = 0u; return __builtin_bit_cast(bf16x8, w); }
#define MFMA16(A, B, Cc) __builtin_amdgcn_mfma_f32_16x16x32_bf16((A), (B), (Cc), 0, 0, 0)

struct S5C { f32x4 ar[4], ai[4]; bf16x8 Bf[8], Cf[4], Wv, Wg; f32x4 dsk, bv, bg; };
__device__ __forceinline__ void s5_load_consts(S5C& K, const Args& a, int g, int lane) {
    const int fr = lane & 15, q = lane >> 4;
    const float* ABAR = (const float*)(a.ws + WS_S5C + S5C_ABAR) + (size_t)g * 128;
    const bf16* BBAR = (const bf16*)(a.ws + WS_S5C + S5C_BBAR) + (size_t)g * 2048;
#pragma unroll
    for (int j = 0; j < 4; ++j) { const f32x4 x0 = *(const f32x4*)(ABAR + 2 * (16 * j + 4 * q)), x1 = *(const f32x4*)(ABAR + 2 * (16 * j + 4 * q) + 4);
        K.ar[j] = (f32x4){x0[0], x0[2], x1[0], x1[2]}; K.ai[j] = (f32x4){x0[1], x0[3], x1[1], x1[3]}; }
#pragma unroll
    for (int mt = 0; mt < 8; ++mt) K.Bf[mt] = raw4z(*(const v2u*)(BBAR + (mt * 16 + fr) * 16 + 4 * q));
    const float* cre = a.in[I_CRE] + ((size_t)g * 16 + fr) * 64; const float* cim = a.in[I_CIM] + ((size_t)g * 16 + fr) * 64;
#pragma unroll
    for (int j = 0; j < 4; ++j) { const f32x4 r4 = *(const f32x4*)(cre + 16 * j + 4 * q), i4 = *(const f32x4*)(cim + 16 * j + 4 * q); K.Cf[j] = pack8(r4, -i4); }
    const float* wg = a.in[I_WGLU] + (size_t)g * 512;
    { f32x4 v, gt;
#pragma unroll
      for (int e = 0; e < 4; ++e) { v[e] = wg[(4 * q + e) * 32 + fr]; gt[e] = wg[(4 * q + e) * 32 + 16 + fr]; }
      K.Wv = pack4z(v); K.Wg = pack4z(gt); }
    K.dsk = *(const f32x4*)(a.in[I_DSKIP] + g * 16 + 4 * q);
    K.bv = *(const f32x4*)(a.in[I_BGLU] + g * 32 + 4 * q); K.bg = *(const f32x4*)(a.in[I_BGLU] + g * 32 + 16 + 4 * q);
}
#define S5_UPDATE(K, hre, him, xq) do { const bf16x8 xb_ = raw4z(xq); \
    _Pragma("unroll") for (int j = 0; j < 4; ++j) { const f32x4 cre_ = K.ar[j] * hre[j] - K.ai[j] * him[j], cim_ = K.ar[j] * him[j] + K.ai[j] * hre[j]; \
        hre[j] = MFMA16(K.Bf[2 * j], xb_, cre_); him[j] = MFMA16(K.Bf[2 * j + 1], xb_, cim_); } } while (0)
__device__ __forceinline__ v2u s5_output(const S5C& K, const f32x4 (&hre)[4], const f32x4 (&him)[4], v2u xq, v2u zq) {
    f32x4 y = (f32x4){0.f, 0.f, 0.f, 0.f};
#pragma unroll
    for (int j = 0; j < 4; ++j) y = MFMA16(K.Cf[j], pack8(hre[j], him[j]), y);
    const f32x4 xf = (f32x4){bf_lo(xq.x), bf_hi(xq.x), bf_lo(xq.y), bf_hi(xq.y)};
    y = y + K.dsk * xf;
    const bf16x8 yb = pack4z(y);
    const f32x4 gv = MFMA16(K.Wv, yb, K.bv), gg = MFMA16(K.Wg, yb, K.bg);
    const f32x4 zf = (f32x4){bf_lo(zq.x), bf_hi(zq.x), bf_lo(zq.y), bf_hi(zq.y)};
    f32x4 o;
#pragma unroll
    for (int r = 0; r < 4; ++r) o[r] = gv[r] * __builtin_amdgcn_rcpf(1.0f + __expf(-gg[r])) * zf[r];
    return (v2u){pk2(o[0], o[1]), pk2(o[2], o[3])};
}

__device__ __forceinline__ void s5_prompt_task(const Args& a, const Ctx& C, int b, int g) {
    const bf16* PROJ = (const bf16*)(a.ws + WS_PROJ); bf16* Y = (bf16*)(a.ws + WS_Y);
    LAS unsigned char* XS = C.lds;
    LAS float* SH = (LAS float*)(C.lds + 67584);
    LAS float* TW = (LAS float*)(C.lds + 67584 + 128 * 132 * 4);
    const int lane = C.lane, n = lane & 15, q = lane >> 4, w = C.wave;
    const size_t row0 = (size_t)b * SEQ;
    __syncthreads();
    for (int i = C.tid; i < 4096; i += 512) { const int tok = i >> 1, hf = i & 1;
        *(LAS v4u*)(XS + tok * 32 + (tok >> 4) * 16 + hf * 16) = *(const v4u*)(PROJ + (row0 + tok) * DIN + 3072 + g * 16 + hf * 8); }
    S5C K; s5_load_consts(K, a, g, lane);
    __syncthreads();
    const int chunk = 16 * w + n;
    f32x4 hre[4], him[4];
#pragma unroll
    for (int j = 0; j < 4; ++j) { hre[j] = (f32x4){0.f, 0.f, 0.f, 0.f}; him[j] = (f32x4){0.f, 0.f, 0.f, 0.f}; }
    const LAS unsigned char* xsl = XS + chunk * 528 + q * 8;
    for (int t = 0; t < 16; ++t) { const v2u xq = *(const LAS v2u*)(xsl + t * 32); S5_UPDATE(K, hre, him, xq); }
#pragma unroll
    for (int j = 0; j < 4; ++j) { LAS float* d = SH + chunk * 132 + 2 * (16 * j + 4 * q);
        *(LAS f32x4*)d = (f32x4){hre[j][0], him[j][0], hre[j][1], him[j][1]}; *(LAS f32x4*)(d + 4) = (f32x4){hre[j][2], him[j][2], hre[j][3], him[j][3]}; }
    v2u zq[4];
#pragma unroll
    for (int t = 0; t < 4; ++t) zq[t] = *(const v2u*)(PROJ + (row0 + 16 * chunk + t) * DIN + 4096 + g * 16 + 4 * q);
    LDS_WAIT();
    { const float* A16 = (const float*)(a.ws + WS_S5C + S5C_A16) + (size_t)g * 128; const float* A256 = (const float*)(a.ws + WS_S5C + S5C_A256) + (size_t)g * 128;
      const float a16r = A16[2 * lane], a16i = A16[2 * lane + 1], a256r = A256[2 * lane], a256i = A256[2 * lane + 1];
      float tr = 0.f, ti = 0.f;
      for (int i = 0; i < 16; ++i) { const float sr = SH[(16 * w + i) * 132 + 2 * lane], si = SH[(16 * w + i) * 132 + 2 * lane + 1];
          const float nr = a16r * tr - a16i * ti + sr, ni = a16r * ti + a16i * tr + si; tr = nr; ti = ni; }
      TW[w * 128 + 2 * lane] = tr; TW[w * 128 + 2 * lane + 1] = ti;
      __syncthreads();
      float hr = 0.f, hi = 0.f;
      for (int v = 0; v < w; ++v) { const float sr = TW[v * 128 + 2 * lane], si = TW[v * 128 + 2 * lane + 1];
          const float nr = a256r * hr - a256i * hi + sr, ni = a256r * hi + a256i * hr + si; hr = nr; hi = ni; }
      for (int i = 0; i < 16; ++i) { LAS float* s = SH + (16 * w + i) * 132 + 2 * lane; const float sr = s[0], si = s[1];
          s[0] = hr; s[1] = hi;
          const float nr = a16r * hr - a16i * hi + sr, ni = a16r * hi + a16i * hr + si; hr = nr; hi = ni; }
      if (w == 7) { a.out[OUT_HPRE + ((size_t)b * NG + g) * PST + lane] = hr; a.out[OUT_HPIM + ((size_t)b * NG + g) * PST + lane] = hi; }
      LDS_WAIT(); }
#pragma unroll
    for (int j = 0; j < 4; ++j) { const LAS float* s = SH + chunk * 132 + 2 * (16 * j + 4 * q); const f32x4 x0 = *(const LAS f32x4*)s, x1 = *(const LAS f32x4*)(s + 4);
        hre[j] = (f32x4){x0[0], x0[2], x1[0], x1[2]}; him[j] = (f32x4){x0[1], x0[3], x1[1], x1[3]}; }
#pragma unroll 1
    for (int t0 = 0; t0 < 16; t0 += 4) {
#pragma unroll
        for (int u = 0; u < 4; ++u) { const int t = t0 + u, tok = 16 * chunk + t;
            const v2u xq = *(const LAS v2u*)(xsl + t * 32);
            S5_UPDATE(K, hre, him, xq);
            *(v2u*)(Y + (row0 + tok) * DM + DA + g * 16 + 4 * q) = s5_output(K, hre, him, xq, zq[u]);
            const int tn = (t + 4 < 16) ? tok + 4 : tok;
            zq[u] = *(const v2u*)(PROJ + (row0 + tn) * DIN + 4096 + g * 16 + 4 * q); } }
}
__device__ __forceinline__ void s5_sample_task(const Args& a, int rb, int g, int lane) {
    const bf16* PROJ = (const bf16*)(a.ws + WS_PROJ); bf16* Y = (bf16*)(a.ws + WS_Y);
    const int n = lane & 15, q = lane >> 4, i = 16 * rb + n; const size_t row = (size_t)NBATCH * SEQ + i;
    S5C K; s5_load_consts(K, a, g, lane);
    f32x4 hre[4], him[4];
    const float* sre = a.in[I_SRE] + ((size_t)i * NG + g) * PST; const float* sim = a.in[I_SIM] + ((size_t)i * NG + g) * PST;
#pragma unroll
    for (int j = 0; j < 4; ++j) { hre[j] = *(const f32x4*)(sre + 16 * j + 4 * q); him[j] = *(const f32x4*)(sim + 16 * j + 4 * q); }
    const v2u xq = *(const v2u*)(PROJ + row * DIN + 3072 + g * 16 + 4 * q), zq = *(const v2u*)(PROJ + row * DIN + 4096 + g * 16 + 4 * q);
    S5_UPDATE(K, hre, him, xq);
    float* ore = a.out + OUT_HSRE + ((size_t)i * NG + g) * PST; float* oim = a.out + OUT_HSIM + ((size_t)i * NG + g) * PST;
#pragma unroll
    for (int j = 0; j < 4; ++j) { *(f32x4*)(ore + 16 * j + 4 * q) = hre[j]; *(f32x4*)(oim + 16 * j + 4 * q) = him[j]; }
    *(v2u*)(Y + row * DM + DA + g * 16 + 4 * q) = s5_output(K, hre, him, xq, zq);
}
__device__ __forceinline__ void gmlp_tile(const Args& a, const Ctx& C, int c, int hd) {
    const bf16* PROJ = (const bf16*)(a.ws + WS_PROJ); bf16* Y = (bf16*)(a.ws + WS_Y);
    const float* VST = (const float*)(a.ws + WS_CTL) + CW_VSTAT;
    const int lane = C.lane, fr = lane & 15, q = lane >> 4, w = C.wave;
    const size_t T0 = (size_t)c * 128; const int ch = hd * 128 + 16 * w + fr;
    const float lg = a.in[I_LNG][ch], lb = a.in[I_LNB][ch];
    LAS float* ST = (LAS float*)C.lds;
    __syncthreads();
    if (C.tid < 128) { const size_t row = T0 + C.tid; const float s1 = ld_agent_f32(VST + 2 * row), s2 = ld_agent_f32(VST + 2 * row + 1);
        const float mu = s1 * (1.0f / DA), var = s2 * (1.0f / DA) - mu * mu; ST[2 * C.tid] = mu; ST[2 * C.tid + 1] = __builtin_amdgcn_rsqf(var + EPS); }
    __syncthreads();
    bf16x8 af[4];
#pragma unroll
    for (int ks = 0; ks < 4; ++ks) { f32x4 lo, hi;
#pragma unroll
        for (int e = 0; e < 8; ++e) { const int sl = 32 * ks + 8 * q + e; const size_t row = T0 + sl;
            const float mu = ST[2 * sl], rs = ST[2 * sl + 1];
            const float v = __uint_as_float((unsigned)PROJ[row * DIN + DA + ch] << 16);
            const float x = (v - mu) * rs * lg + lb; if (e < 4) lo[e] = x; else hi[e - 4] = x; }
        af[ks] = pack8(lo, hi); }
    const float* W = a.in[I_WS] + (size_t)hd * 128 * 128;
    f32x4 acc[8];
#pragma unroll
    for (int nt = 0; nt < 8; ++nt) { acc[nt] = (f32x4){0.f, 0.f, 0.f, 0.f};
        const int t = 16 * nt + fr;
#pragma unroll
        for (int ks = 0; ks <= nt / 2; ++ks) { const int s0 = 32 * ks + 8 * q; f32x4 lo = *(const f32x4*)(W + t * 128 + s0), hi = *(const f32x4*)(W + t * 128 + s0 + 4);
#pragma unroll
            for (int e = 0; e < 4; ++e) { lo[e] = (s0 + e <= t) ? lo[e] : 0.f; hi[e] = (s0 + 4 + e <= t) ? hi[e] : 0.f; }
            acc[nt] = MFMA16(af[ks], pack8(lo, hi), acc[nt]); } }
    const int chs = hd * 128 + 16 * w + 4 * q;
#pragma unroll
    for (int nt = 0; nt < 8; ++nt) { const int t = 16 * nt + fr; const size_t row = T0 + t; const float bs = a.in[I_BS][hd * 128 + t];
        const v2u uq = *(const v2u*)(PROJ + row * DIN + chs), zq = *(const v2u*)(PROJ + row * DIN + 2 * DA + chs);
        const float o0 = bf_lo(uq.x) * (acc[nt][0] + bs) * bf_lo(zq.x), o1 = bf_hi(uq.x) * (acc[nt][1] + bs) * bf_hi(zq.x);
        const float o2 = bf_lo(uq.y) * (acc[nt][2] + bs) * bf_lo(zq.y), o3 = bf_hi(uq.y) * (acc[nt][3] + bs) * bf_hi(zq.y);
        *(v2u*)(Y + row * DM + chs) = (v2u){pk2(o0, o1), pk2(o2, o3)}; }
}
__device__ __forceinline__ void p4_mixers(const Args& a, const Ctx& C) {
    const bf16* PROJ = (const bf16*)(a.ws + WS_PROJ); bf16* Y = (bf16*)(a.ws + WS_Y);
    const float* VST = (const float*)(a.ws + WS_CTL) + CW_VSTAT;
    const int gt = C.vcu * 512 + C.tid, NT = C.G * 512;
    for (int i = gt; i < (MP - MTOK) * DM / 8; i += NT) ((v4u*)(Y + (size_t)MTOK * DM))[i] = (v4u){0u, 0u, 0u, 0u};
    for (int i = gt; i < DEC * DA / 4; i += NT) { const int r = i >> 8, c4 = (i & 255) * 4, hd = c4 >> 7; const size_t row = (size_t)NBATCH * SEQ + r;
        const float s1 = ld_agent_f32(VST + 2 * row), s2 = ld_agent_f32(VST + 2 * row + 1);
        const float mu = s1 * (1.0f / DA), var = s2 * (1.0f / DA) - mu * mu, rs = __builtin_amdgcn_rsqf(var + EPS);
        const v2u vq = *(const v2u*)(PROJ + row * DIN + DA + c4), uq = *(const v2u*)(PROJ + row * DIN + c4), zq = *(const v2u*)(PROJ + row * DIN + 2 * DA + c4);
        const f32x4 lg = *(const f32x4*)(a.in[I_LNG] + c4), lb = *(const f32x4*)(a.in[I_LNB] + c4);
        const f32x4 vf = (f32x4){bf_lo(vq.x), bf_hi(vq.x), bf_lo(vq.y), bf_hi(vq.y)}, uf = (f32x4){bf_lo(uq.x), bf_hi(uq.x), bf_lo(uq.y), bf_hi(uq.y)}, zf = (f32x4){bf_lo(zq.x), bf_hi(zq.x), bf_lo(zq.y), bf_hi(zq.y)};
        const f32x4 ln = (vf - mu) * rs * lg + lb;
        *(f32x4*)(a.out + OUT_VS + (size_t)r * DA + c4) = ln;
        const float w00 = a.in[I_WS][(size_t)hd * 128 * 128], bs0 = a.in[I_BS][hd * 128];
        const f32x4 o = uf * (ln * w00 + bs0) * zf;
        *(v2u*)(Y + row * DM + c4) = (v2u){pk2(o[0], o[1]), pk2(o[2], o[3])}; }
    if (C.wave < 2) { for (int wt = C.vcu * 2 + C.wave; wt < 8 * NG; wt += C.G * 2) s5_sample_task(a, wt >> 6, wt & 63, C.lane); }
    for (int tt = C.vcu; tt < 512; tt += C.G) gmlp_tile(a, C, tt >> 3, tt & 7);
    for (int tt = C.vcu; tt < NBATCH * NG; tt += C.G) s5_prompt_task(a, C, tt >> 6, tt & 63);
}

__device__ __forceinline__ void p6_final(const Args& a, const Ctx& C) {
    const float* MOD = (const float*)(a.ws + WS_MOD); const bf16* O = (const bf16*)(a.ws + WS_O); const float* OSQ = (const float*)(a.ws + WS_CTL) + CW_OSQ; const float* gpost = a.in[I_GPOST];
    const int gw = C.vcu * NWAVES + C.wave, NGW = C.G * NWAVES, lane = C.lane;
    for (int r = gw; r < MTOK; r += NGW) {
        const float* xrow = (r < NBATCH * SEQ) ? a.in[I_XP] + (size_t)r * DM : a.in[I_XS] + (size_t)(r - NBATCH * SEQ) * DM;
        const int b = (r < NBATCH * SEQ) ? (r >> 11) : NBATCH + (r - NBATCH * SEQ);
        const float* gate = MOD + (size_t)b * 6144 + 2 * DM;
        const float rinv = __builtin_amdgcn_rsqf(ld_agent_f32(OSQ + r) * (1.0f / DM) + EPS);
        const v4u* orow = (const v4u*)(O + (size_t)r * DM); float* outr = a.out + (size_t)r * DM;
#pragma unroll
        for (int j = 0; j < 4; ++j) { const int c8 = lane + 64 * j; const v4u ov = orow[c8];
            const f32x4 x0 = ((const f32x4*)xrow)[2 * c8], x1 = ((const f32x4*)xrow)[2 * c8 + 1], g0 = ((const f32x4*)gate)[2 * c8], g1 = ((const f32x4*)gate)[2 * c8 + 1], p0 = ((const f32x4*)gpost)[2 * c8], p1 = ((const f32x4*)gpost)[2 * c8 + 1];
            const f32x4 o0 = (f32x4){bf_lo(ov.x), bf_hi(ov.x), bf_lo(ov.y), bf_hi(ov.y)}, o1 = (f32x4){bf_lo(ov.z), bf_hi(ov.z), bf_lo(ov.w), bf_hi(ov.w)};
            ((f32x4*)outr)[2 * c8] = x0 + g0 * (o0 * rinv * p0); ((f32x4*)outr)[2 * c8 + 1] = x1 + g1 * (o1 * rinv * p1); }
    }
}

__global__ void __launch_bounds__(NWAVES * 64, 2) hymba_fwd(Args args) {
    extern __shared__ __attribute__((aligned(16))) unsigned char lds_raw[];
    Ctx C; C.lds = (LAS unsigned char*)lds_raw;
    C.tid = threadIdx.x; C.lane = C.tid & 63; C.wave = __builtin_amdgcn_readfirstlane(C.tid >> 6);
    C.G = gridDim.x; { const int bx = blockIdx.x; C.vcu = (C.G % 8 == 0) ? (bx % 8) * (C.G / 8) + bx / 8 : bx; }
    gu32* ctl = (gu32*)(args.ws + WS_CTL);
    volatile LAS unsigned* MISC = (volatile LAS unsigned*)(C.lds + MISC_OFF);
    for (int u = C.tid; u < (LDS_BYTES - LDSCTL_OFF) / 4; u += NWAVES * 64) ((LAS unsigned*)(C.lds + LDSCTL_OFF))[u] = 0u;
    __syncthreads();
    XcdBarrier bar; bar.bar = (unsigned*)(ctl + CW_BAR); bar.x = 0; bar.st = nullptr;
    if (N_LAUNCHES != PER_PHASE) bar = xcd_barrier_post((unsigned*)(ctl + CW_BAR), MISC + 8);
    const int lo = args.ph_lo, hi = args.ph_hi;
#define IN(k) (lo <= (k) && (k) < hi)
#define SEAM(k) do { if (IN(k) && IN((k) + 1)) xcd_barrier(bar); } while (0)
    if (IN(0)) { p0_prologue(args, C); SEAM(0); }
    if (IN(1)) { p1_adaln(args, C); SEAM(1); }
    if (IN(2)) { p2_prenorm(args, C); SEAM(2); }
    if (IN(3)) {
        pg8::Gemm g{(const bf16*)(args.ws + WS_H), (const bf16*)(args.ws + WS_WIN), MP, DIN, DM}; pg8::StaticOrder S; S.init(MP, DIN, C.G, (int)blockIdx.x);
        pg8::EpiProj E{(bf16*)(args.ws + WS_PROJ), (float*)(args.ws + WS_CTL) + CW_VSTAT};
        pg8::gemm_phase<pg8::EpiProj, pg8::StaticOrder, true, true>(C.lds, g, S, E);
        SEAM(3);
    }
    if (IN(4)) { p4_mixers(args, C); SEAM(4); }
    if (IN(5)) {
        pg8::Gemm g{(const bf16*)(args.ws + WS_Y), (const bf16*)(args.ws + WS_WOUT), MP, DM, DM}; pg8::StaticOrder S; S.init(MP, DM, C.G, (int)blockIdx.x);
        pg8::EpiO E{(bf16*)(args.ws + WS_O), (float*)(args.ws + WS_CTL) + CW_OSQ};
        pg8::gemm_phase<pg8::EpiO, pg8::StaticOrder, true, true>(C.lds, g, S, E);
        SEAM(5);
    }
    if (IN(6)) { p6_final(args, C); }
#undef IN
#undef SEAM
}

extern "C" void kernel_launch(void* const* d_in, const int* in_sizes, int n_in, void* d_out, int out_size, void* d_ws, size_t ws_size, hipStream_t stream) {
    static int grid = 0;
    if (grid == 0) {
        if (n_in != N_IN || ws_size < WS_END) { fprintf(stderr, "kernel_launch: built for %d inputs and >= %zu bytes of workspace; got %d, %zu\n", (int)N_IN, (size_t)WS_END, n_in, ws_size); grid = -1; return; }
        int dev = 0, cus = 0, per_cu = 0;
        if (hipGetDevice(&dev) != hipSuccess || hipDeviceGetAttribute(&cus, hipDeviceAttributeMultiprocessorCount, dev) != hipSuccess) { grid = -1; return; }
        if (hipFuncSetAttribute((const void*)hymba_fwd, hipFuncAttributeMaxDynamicSharedMemorySize, LDS_BYTES) != hipSuccess) { fprintf(stderr, "kernel_launch: hipFuncSetAttribute failed\n"); grid = -1; return; }
        if (hipOccupancyMaxActiveBlocksPerMultiprocessor(&per_cu, (const void*)hymba_fwd, NWAVES * 64, LDS_BYTES) != hipSuccess || per_cu < 1) { fprintf(stderr, "kernel_launch: occupancy query reports %d workgroups per CU\n", per_cu); }
        (void)hipGetLastError();
        grid = cus;
    }
    if (grid < 0) return;
    if (hipMemsetAsync((char*)d_ws + WS_CTL, 0, CTL_ZERO_BYTES, stream) != hipSuccess) return;
    Args a{};
    for (int i = 0; i < N_IN; ++i) a.in[i] = (const float*)d_in[i];
    a.out = (float*)d_out; a.ws = (unsigned char*)d_ws;
    if (N_LAUNCHES == 1) { a.ph_lo = 0; a.ph_hi = PER_PHASE; hipLaunchKernelGGL(hymba_fwd, dim3(grid), dim3(NWAVES * 64), LDS_BYTES, stream, a); }
    else { for (int li = 0; li < PER_PHASE; ++li) { a.ph_lo = li; a.ph_hi = li + 1; hipLaunchKernelGGL(hymba_fwd, dim3(grid), dim3(NWAVES * 64), LDS_BYTES, stream, a); } }
}
```
